# Optimizing an MI355X kernel written in HIP

```python
import jax, jax.numpy as jnp
from jax import lax
import numpy as np

D_MODEL = 1024
BATCH = 4
SEQ = 4096
DEPTH = 2

D_MIX = D_MODEL
A_WIDTH = D_MIX // 4
A_GROUPS = 4
A_GROUP_DIM = A_WIDTH // A_GROUPS
A_CHUNK = 128
B_WIDTH = D_MIX // 4
B_EXPAND = 64
B_HEADS = B_WIDTH // B_EXPAND
B_KDIM = B_EXPAND
B_VDIM = B_WIDTH // B_HEADS
B_FDIM = B_HEADS * B_KDIM
B_CHUNK = 128
C_WIDTH = D_MIX - A_WIDTH - B_WIDTH
C_HEAD_DIM = 64
C_HEADS = C_WIDTH // C_HEAD_DIM
C_BLOCK = 128
COL_WIDTHS = (A_WIDTH, A_WIDTH, A_WIDTH,
              B_FDIM, B_FDIM, B_WIDTH, B_WIDTH,
              C_WIDTH, C_WIDTH, C_WIDTH, C_WIDTH, C_HEADS)
D_IN = 3 * A_WIDTH + 2 * B_FDIM + 2 * B_WIDTH + 4 * C_WIDTH + C_HEADS
NORM_EPS = 1e-6
F_FLOOR = 1e-30

kernel_name = "hybrid_gmlp_hgrn2_fox_parallel_heads"


def _rmsnorm(x, g):
    xf = x.astype(jnp.float32)
    y = xf * lax.rsqrt(jnp.mean(xf * xf, axis=-1, keepdims=True) + NORM_EPS)
    return (y * g.astype(jnp.float32)).astype(x.dtype)


def _split_cols(proj):
    offsets = []
    acc = 0
    for w in COL_WIDTHS[:-1]:
        acc += w
        offsets.append(acc)
    return jnp.split(proj, offsets, axis=-1)


def _gmlp_mixer(u, v, ln_g, ln_b, w_s, b_s):
    bsz, seq, _ = u.shape
    nc = seq // A_CHUNK
    u = jax.nn.gelu(u)
    v = jax.nn.gelu(v).reshape(bsz, nc, A_CHUNK, A_GROUPS, A_GROUP_DIM)
    vf = v.astype(jnp.float32)
    mu = jnp.mean(vf, axis=-1, keepdims=True)
    var = jnp.mean(jnp.square(vf - mu), axis=-1, keepdims=True)
    vn = (vf - mu) * lax.rsqrt(var + NORM_EPS) * ln_g.astype(jnp.float32) + ln_b.astype(jnp.float32)
    causal = jnp.tril(jnp.ones((A_CHUNK, A_CHUNK), dtype=bool))
    w = jnp.where(causal[None], w_s.astype(jnp.float32), 0.0)
    mixed = jnp.einsum('gts,bnsgc->bntgc', w, vn)
    mixed = mixed + jnp.transpose(b_s.astype(jnp.float32))[None, None, :, :, None]
    return u * mixed.reshape(bsz, seq, A_WIDTH).astype(u.dtype)


def _hgrn2_mixer(q, f_logit, i, lb, onorm_g):
    bsz, seq, _ = q.shape
    nc = seq // B_CHUNK
    qf = jax.nn.silu(q.astype(jnp.float32)) * (B_KDIM ** -0.5)
    z = f_logit.astype(jnp.float32)
    f = lb + (1.0 - lb) * jax.nn.sigmoid(z)
    log_f = jnp.log(jnp.maximum(f, F_FLOOR))
    kf = (1.0 - lb) * jax.nn.sigmoid(-z)
    vf = i.astype(jnp.float32)

    def to_chunks(t, d):
        return t.reshape(bsz, nc, B_CHUNK, B_HEADS, d).transpose(1, 0, 3, 2, 4)

    qc, kc, gc = to_chunks(qf, B_KDIM), to_chunks(kf, B_KDIM), to_chunks(log_f, B_KDIM)
    vc = to_chunks(vf, B_VDIM)
    causal = jnp.tril(jnp.ones((B_CHUNK, B_CHUNK), dtype=bool))[None, None, :, :, None]

    def step(state, inp):
        qx, kx, vx, gx = inp
        b = jnp.cumsum(gx, axis=2)
        o_inter = jnp.einsum('bhtk,bhkv->bhtv', qx * jnp.exp(b), state)
        diff = b[:, :, :, None, :] - b[:, :, None, :, :]
        decay = jnp.exp(jnp.where(causal, diff, -jnp.inf))
        scores = jnp.einsum('bhtk,bhsk,bhtsk->bhts', qx, kx, decay)
        o_intra = jnp.einsum('bhts,bhsv->bhtv', scores, vx)
        b_last = b[:, :, -1:, :]
        new_state = (jnp.exp(b_last[:, :, 0, :])[..., None] * state
                     + jnp.einsum('bhsk,bhsv->bhkv', kx * jnp.exp(b_last - b), vx))
        return new_state, o_inter + o_intra

    state0 = jnp.zeros((bsz, B_HEADS, B_KDIM, B_VDIM), jnp.float32)
    _, ys = lax.scan(step, state0, (qc, kc, vc, gc))
    o = ys.transpose(1, 0, 3, 2, 4).reshape(bsz, seq, B_HEADS, B_VDIM)
    o = o * lax.rsqrt(jnp.mean(o * o, axis=-1, keepdims=True) + NORM_EPS) * onorm_g.astype(jnp.float32)
    return o.reshape(bsz, seq, B_WIDTH).astype(q.dtype)


def _fox_mixer(q, k, v, f_logit, b_f):
    bsz, seq, _ = q.shape

    def heads(t):
        return t.reshape(bsz, seq, C_HEADS, C_HEAD_DIM).transpose(0, 2, 1, 3)

    qh, kh, vh = heads(q), heads(k), heads(v)
    log_f = jax.nn.log_sigmoid(f_logit.astype(jnp.float32) + b_f.astype(jnp.float32))
    c = jnp.cumsum(jnp.transpose(log_f, (0, 2, 1)), axis=-1)
    scale = C_HEAD_DIM ** -0.5
    diag_mask = jnp.tril(jnp.ones((C_BLOCK, C_BLOCK), dtype=bool))
    outs = []
    for blk in range(seq // C_BLOCK):
        q0 = blk * C_BLOCK
        q1 = q0 + C_BLOCK
        s = jnp.einsum('bhqd,bhkd->bhqk', qh[:, :, q0:q1], kh[:, :, :q1]).astype(jnp.float32) * scale
        s = s + c[:, :, q0:q1, None] - c[:, :, None, :q1]
        mask = jnp.concatenate([jnp.ones((C_BLOCK, q0), dtype=bool), diag_mask], axis=1)
        s = jnp.where(mask[None, None], s, -jnp.inf)
        p = jax.nn.softmax(s, axis=-1)
        outs.append(jnp.einsum('bhqk,bhkd->bhqd', p.astype(vh.dtype), vh[:, :, :q1]))
    o = jnp.concatenate(outs, axis=2)
    return o.transpose(0, 2, 1, 3).reshape(bsz, seq, C_WIDTH)


def setup_inputs(seed: int = 0) -> dict:
    key = jax.random.key(seed)
    ks = jax.random.split(key, 13)
    f32 = jnp.float32
    x = jax.random.normal(ks[0], (BATCH, SEQ, D_MODEL), f32)
    norm_g = 1.0 + 0.05 * jax.random.normal(ks[1], (DEPTH, D_MODEL), f32)
    w_in = jax.random.normal(ks[2], (DEPTH, D_MODEL, D_IN), f32) * D_MODEL ** -0.5
    w_out = jax.random.normal(ks[3], (DEPTH, D_MIX, D_MODEL), f32) * (D_MIX ** -0.5) * (2 * DEPTH) ** -0.5
    gmlp_ln_g = 1.0 + 0.05 * jax.random.normal(ks[4], (DEPTH, A_GROUPS, A_GROUP_DIM), f32)
    gmlp_ln_b = 0.02 * jax.random.normal(ks[5], (DEPTH, A_GROUPS, A_GROUP_DIM), f32)
    gmlp_w_s = jax.random.normal(ks[6], (DEPTH, A_GROUPS, A_CHUNK, A_CHUNK), f32) * A_CHUNK ** -0.5
    gmlp_b_s = 1.0 + 0.1 * jax.random.normal(ks[7], (DEPTH, A_GROUPS, A_CHUNK), f32)
    hgrn_lb = 0.1 * jax.random.normal(ks[8], (DEPTH, B_FDIM), f32)
    hgrn_onorm_g = 1.0 + 0.05 * jax.random.normal(ks[9], (DEPTH, B_VDIM), f32)
    fox_b_f = jax.random.uniform(ks[10], (DEPTH, C_HEADS), f32, 0.0, 3.0)
    final_norm_g = 1.0 + 0.05 * jax.random.normal(ks[11], (D_MODEL,), f32)
    return {"x": x, "norm_g": norm_g, "w_in": w_in, "w_out": w_out,
            "gmlp_ln_g": gmlp_ln_g, "gmlp_ln_b": gmlp_ln_b, "gmlp_w_s": gmlp_w_s,
            "gmlp_b_s": gmlp_b_s, "hgrn_lb": hgrn_lb, "hgrn_onorm_g": hgrn_onorm_g,
            "fox_b_f": fox_b_f, "final_norm_g": final_norm_g}


def reference(x, norm_g, w_in, w_out, gmlp_ln_g, gmlp_ln_b, gmlp_w_s, gmlp_b_s,
              hgrn_lb, hgrn_onorm_g, fox_b_f, final_norm_g):
    p = jax.nn.softmax(hgrn_lb.astype(jnp.float32), axis=0)
    lb_all = jnp.clip(jnp.cumsum(p, axis=0) - p[0:1], 0.0, 1.0 - 1e-6)
    for layer in range(DEPTH):
        h = _rmsnorm(x, norm_g[layer])
        proj = jnp.einsum('bsd,de->bse', h, w_in[layer])
        (a_u, a_v, a_z, b_q, b_fl, b_i, b_z,
         c_q, c_k, c_v, c_z, c_fl) = _split_cols(proj)
        y_a = _gmlp_mixer(a_u, a_v, gmlp_ln_g[layer], gmlp_ln_b[layer],
                          gmlp_w_s[layer], gmlp_b_s[layer]) * jax.nn.silu(a_z)
        y_b = _hgrn2_mixer(b_q, b_fl, b_i, lb_all[layer], hgrn_onorm_g[layer]) * jax.nn.silu(b_z)
        y_c = _fox_mixer(c_q, c_k, c_v, c_fl, fox_b_f[layer]) * jax.nn.silu(c_z)
        y = jnp.concatenate([y_a, y_b, y_c], axis=-1)
        x = x + jnp.einsum('bse,ed->bsd', y, w_out[layer])
    return _rmsnorm(x, final_norm_g)
```

```cpp
#include <hip/hip_runtime.h>
#include <hip/hip_cooperative_groups.h>
#include <cstdio>
#include <cstdint>
#include <type_traits>
namespace cg = cooperative_groups;
namespace pg8 {
#define PG8_LAS __attribute__((address_space(3)))
typedef unsigned short bf16_t;
typedef short bf16x8 __attribute__((ext_vector_type(8)));
typedef float f32x4 __attribute__((ext_vector_type(4)));
typedef unsigned u32x4 __attribute__((ext_vector_type(4)));
constexpr int BM = 256, BK = 64, HALF = 128, HTB = HALF * BK * 2  , STAGE_BYTES = 8 * HTB, NXCD = 8, WGM = 8;

__host__ __device__ __forceinline__ int lds_byte(int r, int c) { const int st = (r >> 4) * 2 + (c >> 5), rr = r & 15, cc = c & 31, ob = rr * 64 + cc * 2; return st * 1024 + (ob ^ (((ob >> 9) & 1) << 5)); }
__host__ __device__ __forceinline__ void stage_rc(int b, int& R, int& C) { const int st = b / 1024, sb = b % 1024, swz = sb ^ (((sb >> 9) & 1) << 5); R = (st >> 1) * 16 + swz / 64; C = (st & 1) * 32 + (swz % 64) / 2; }
__host__ __device__ __forceinline__ int perm32(int rho) { const int n = rho >> 4, i = rho & 15; return 8 * (i >> 2) + 4 * n + (i & 3); }

struct Unit { int pm, pn; };
struct Gemm { const bf16_t* A; const bf16_t* Bt; int M, N, K; };

struct StaticOrder {
    int nM, nN, nwg, G, c;
    __host__ __device__ void init(int M, int N, int G_, int c_) { nM = M / BM; nN = N / BM; nwg = nM * nN; G = G_; c = c_; }
    __host__ __device__ bool next(int i, Unit& u) const {
        const long L = (long)i * G + c; if (L >= nwg) return false;
        int wgid = (int)L; { const int q = nwg / NXCD, r = nwg % NXCD, xcd = wgid % NXCD, off = wgid / NXCD; wgid = (xcd < r ? xcd * (q + 1) : r * (q + 1) + (xcd - r) * q) + off; }
        const int nig = WGM * nN, gid = wgid / nig, fm = gid * WGM, gsz = (nM - fm) < WGM ? (nM - fm) : WGM;
        u.pm = fm + ((wgid % nig) % gsz); u.pn = (wgid % nig) / gsz; return true;
    }
    __device__ __forceinline__ void a_ready(const Unit&) const {}
    __device__ __forceinline__ void done(const Unit&) const {}
};

__device__ __forceinline__ unsigned cvt_pk_bf16(float lo, float hi) { unsigned r; asm volatile("v_cvt_pk_bf16_f32 %0, %1, %2" : "=v"(r) : "v"(lo), "v"(hi)); return r; }
template <class Epi, class Sched, bool ALIGN_EPI = false, bool SP2 = false>
__device__ __forceinline__ void gemm_phase(PG8_LAS unsigned char* lds, const Gemm g, const Sched& S, const Epi& E) {
    int tid_ = threadIdx.x; asm volatile("" : "+v"(tid_)); const int tid = tid_, wid = __builtin_amdgcn_readfirstlane(tid >> 6), lane = tid & 63, wr = wid >> 2, wc = wid & 3, fr = lane & 15, fq = lane >> 4;
    const int K = g.K, nt = K / BK;
    unsigned voffA[2], voffB[2];
#pragma unroll
    for (int i = 0; i < 2; ++i) { int R, C; stage_rc(tid * 16 + i * 8192, R, C); const int Rb = Epi::PERM ? ((R & ~31) + perm32(R & 31)) : R;
        voffA[i] = (unsigned)(R * K + C) * 2u; voffB[i] = (unsigned)(Rb * K + C) * 2u; }
    const size_t kstep = (size_t)(BK * 2);
    const size_t hstep = (size_t)HALF * K * 2;
    const size_t tstep = 2 * hstep;
    const unsigned ldsw = (unsigned)wid * 1024u;
    const int aoff = lds_byte(wr * 64 + fr, fq * 8), boff = lds_byte(wc * 32 + fr, fq * 8);
#define PG8_SA(b, h) (((b) * 2 + (h)) * HTB)
#define PG8_SB(b, h) ((4 + (b) * 2 + (h)) * HTB)
#define PG8_STAGE(bufoff, gbase, voff) do { _Pragma("unroll") for (int _i = 0; _i < 2; ++_i) \
        __builtin_amdgcn_global_load_lds((const unsigned*)((const char*)(gbase) + (voff)[_i]), (PG8_LAS unsigned*)(lds + (bufoff) + ldsw + _i * 8192), 16, 0, 0); } while (0)
#define PG8_LDA(dst, b, h) do { _Pragma("unroll") for (int m = 0; m < 4; ++m) _Pragma("unroll") for (int k = 0; k < 2; ++k) dst[m][k] = *(const PG8_LAS bf16x8*)(lds + PG8_SA(b, h) + aoff + m * 2048 + k * 1024); } while (0)
#define PG8_LDB(dst, b, h) do { _Pragma("unroll") for (int n = 0; n < 2; ++n) _Pragma("unroll") for (int k = 0; k < 2; ++k) dst[n][k] = *(const PG8_LAS bf16x8*)(lds + PG8_SB(b, h) + boff + n * 2048 + k * 1024); } while (0)
#define PG8_MMA(ai, bj, At, Bt) do { __builtin_amdgcn_s_setprio(1); _Pragma("unroll") for (int m = 0; m < 4; ++m) _Pragma("unroll") for (int n = 0; n < 2; ++n) _Pragma("unroll") for (int k = 0; k < 2; ++k) \
        acc[ai][bj][m][n] = __builtin_amdgcn_mfma_f32_16x16x32_bf16(Bt[n][k], At[m][k], acc[ai][bj][m][n], 0, 0, 0); __builtin_amdgcn_s_setprio(0); } while (0)
#define PG8_WAIT_V(n) asm volatile("s_waitcnt vmcnt(" #n ")" ::: "memory")
#define PG8_WAIT_L(n) asm volatile("s_waitcnt lgkmcnt(" #n ")" ::: "memory")
#define PG8_BAR __builtin_amdgcn_s_barrier()
#define PG8_SCHED __builtin_amdgcn_sched_barrier(0)
    Unit cur, nxt; int ui = 0;
    if (!S.next(0, cur)) return;
    f32x4 acc[2][2][4][2];
#pragma unroll
    for (int a = 0; a < 2; ++a)
#pragma unroll
        for (int b = 0; b < 2; ++b)
#pragma unroll
            for (int m = 0; m < 4; ++m)
#pragma unroll
                for (int n = 0; n < 2; ++n) acc[a][b][m][n] = (f32x4){0.f, 0.f, 0.f, 0.f};
    bf16x8 At[4][2], B0[2][2], B1[2][2];
    const char* cA = (const char*)g.A + (size_t)cur.pm * tstep; const char* cB = (const char*)g.Bt + (size_t)cur.pn * tstep;
    S.a_ready(cur);
    if constexpr (SP2) {
        PG8_STAGE(PG8_SB(0, 0), cB, voffB); PG8_STAGE(PG8_SB(0, 1), cB + hstep, voffB); PG8_STAGE(PG8_SA(0, 0), cA, voffA); PG8_STAGE(PG8_SA(0, 1), cA + hstep, voffA);
        if (wr == 1) PG8_BAR;
        PG8_WAIT_V(2); PG8_BAR;
        PG8_STAGE(PG8_SB(1, 0), cB + kstep, voffB); PG8_STAGE(PG8_SA(1, 0), cA + kstep, voffA); PG8_STAGE(PG8_SB(1, 1), cB + hstep + kstep, voffB);
        PG8_WAIT_V(6); PG8_BAR;
    } else {
        PG8_STAGE(PG8_SB(0, 0), cB, voffB); PG8_STAGE(PG8_SA(0, 0), cA, voffA); PG8_STAGE(PG8_SB(0, 1), cB + hstep, voffB); PG8_STAGE(PG8_SA(0, 1), cA + hstep, voffA);
        if (wr == 1) PG8_BAR;
        PG8_WAIT_V(4); PG8_BAR;
        PG8_STAGE(PG8_SB(1, 0), cB + kstep, voffB); PG8_STAGE(PG8_SA(1, 0), cA + kstep, voffA); PG8_STAGE(PG8_SB(1, 1), cB + hstep + kstep, voffB);
        PG8_WAIT_V(6); PG8_BAR;
    }
    for (;;) {
        const bool has_next = S.next(ui + 1, nxt);
        const char* nA = has_next ? (const char*)g.A + (size_t)nxt.pm * tstep : cA; const char* nB = has_next ? (const char*)g.Bt + (size_t)nxt.pn * tstep : cB;
        for (int t = 0; t < nt; t += 2) {
            const bool last = (t == nt - 2);
            const char* a1 = cA + (size_t)(t + 1) * kstep;
            const char* a2 = last ? nA : cA + (size_t)(t + 2) * kstep; const char* b2 = last ? nB : cB + (size_t)(t + 2) * kstep;
            const char* a3 = a2 + kstep; const char* b3 = b2 + kstep;
            if (last && has_next) S.a_ready(nxt);
            if constexpr (SP2) {
            PG8_LDB(B0, 0, 0); PG8_LDB(B1, 0, 1); PG8_SCHED; PG8_LDA(At, 0, 0); PG8_STAGE(PG8_SA(1, 1), a1 + hstep, voffA);
            PG8_WAIT_V(8); PG8_WAIT_L(0); PG8_BAR; PG8_MMA(0, 0, At, B0); PG8_MMA(0, 1, At, B1); PG8_BAR; PG8_SCHED;
            PG8_LDA(At, 0, 1); PG8_STAGE(PG8_SB(0, 0), b2, voffB); PG8_STAGE(PG8_SB(0, 1), b2 + hstep, voffB); PG8_STAGE(PG8_SA(0, 0), a2, voffA);
            PG8_WAIT_V(8); PG8_WAIT_L(0); PG8_BAR; PG8_MMA(1, 0, At, B0); PG8_MMA(1, 1, At, B1); PG8_BAR; PG8_SCHED;
            PG8_LDB(B0, 1, 0); PG8_LDB(B1, 1, 1); PG8_SCHED; PG8_LDA(At, 1, 0); PG8_STAGE(PG8_SA(0, 1), a2 + hstep, voffA);
            PG8_WAIT_V(8); PG8_WAIT_L(0); PG8_BAR; PG8_MMA(0, 0, At, B0); PG8_MMA(0, 1, At, B1); PG8_BAR; PG8_SCHED;
            PG8_LDA(At, 1, 1); PG8_STAGE(PG8_SB(1, 0), b3, voffB); PG8_STAGE(PG8_SB(1, 1), b3 + hstep, voffB); PG8_STAGE(PG8_SA(1, 0), a3, voffA);
            PG8_WAIT_V(8); PG8_WAIT_L(0); PG8_BAR; PG8_MMA(1, 0, At, B0); PG8_MMA(1, 1, At, B1); PG8_BAR; PG8_SCHED;
            } else {
            PG8_LDB(B0, 0, 0); PG8_SCHED; PG8_LDA(At, 0, 0); PG8_STAGE(PG8_SA(1, 1), a1 + hstep, voffA);
            PG8_WAIT_L(8); PG8_BAR; PG8_WAIT_L(0); PG8_MMA(0, 0, At, B0); PG8_BAR; PG8_SCHED;
            PG8_LDB(B1, 0, 1); PG8_STAGE(PG8_SB(0, 0), b2, voffB);
            PG8_BAR; PG8_WAIT_L(0); PG8_MMA(0, 1, At, B1); PG8_BAR;
            PG8_LDA(At, 0, 1); PG8_STAGE(PG8_SA(0, 0), a2, voffA);
            PG8_BAR; PG8_WAIT_L(0); PG8_MMA(1, 0, At, B0); PG8_BAR; PG8_SCHED;
            PG8_STAGE(PG8_SB(0, 1), b2 + hstep, voffB);
            PG8_WAIT_V(6); PG8_BAR; PG8_MMA(1, 1, At, B1); PG8_BAR;
            PG8_LDB(B0, 1, 0); PG8_SCHED; PG8_LDA(At, 1, 0); PG8_STAGE(PG8_SA(0, 1), a2 + hstep, voffA);
            PG8_WAIT_L(8); PG8_BAR; PG8_WAIT_L(0); PG8_MMA(0, 0, At, B0); PG8_BAR; PG8_SCHED;
            PG8_LDB(B1, 1, 1); PG8_STAGE(PG8_SB(1, 0), b3, voffB);
            PG8_BAR; PG8_WAIT_L(0); PG8_MMA(0, 1, At, B1); PG8_BAR;
            PG8_LDA(At, 1, 1); PG8_STAGE(PG8_SA(1, 0), a3, voffA);
            PG8_BAR; PG8_WAIT_L(0); PG8_MMA(1, 0, At, B0); PG8_BAR; PG8_SCHED;
            PG8_STAGE(PG8_SB(1, 1), b3 + hstep, voffB);
            PG8_WAIT_V(6); PG8_BAR; PG8_MMA(1, 1, At, B1); PG8_BAR;
            }
        }
        if constexpr (ALIGN_EPI) { if (wr == 0) PG8_BAR; }
        if constexpr (!Epi::AFTER_DRAIN) { E(acc, cur, wr, wc, fr, fq); S.done(cur); }
        if (!has_next) break;
#pragma unroll
        for (int a = 0; a < 2; ++a)
#pragma unroll
            for (int b = 0; b < 2; ++b)
#pragma unroll
                for (int m = 0; m < 4; ++m)
#pragma unroll
                    for (int n = 0; n < 2; ++n) acc[a][b][m][n] = (f32x4){0.f, 0.f, 0.f, 0.f};
        cur = nxt; cA = nA; cB = nB; ++ui;
        if constexpr (ALIGN_EPI) { if (wr == 1) PG8_BAR; }
    }
    PG8_WAIT_V(0);
    if constexpr (!ALIGN_EPI) { if (wr == 0) PG8_BAR; }
    PG8_BAR;
    if constexpr (Epi::AFTER_DRAIN) { E.fused(acc, cur, wr, wc, fr, fq, lds, wid, lane); S.done(cur); }
#undef PG8_SA
#undef PG8_SB
#undef PG8_STAGE
#undef PG8_LDA
#undef PG8_LDB
#undef PG8_MMA
#undef PG8_WAIT_V
#undef PG8_WAIT_L
#undef PG8_BAR
#undef PG8_SCHED
}
}

#define DI __device__ __forceinline__
typedef unsigned short bf16_t;
typedef short bf16x8 __attribute__((ext_vector_type(8)));
typedef short s16x4 __attribute__((ext_vector_type(4)));
typedef float f32x4 __attribute__((ext_vector_type(4)));
typedef float f32x16 __attribute__((ext_vector_type(16)));
typedef unsigned u32x4 __attribute__((ext_vector_type(4)));
typedef unsigned u32x2 __attribute__((ext_vector_type(2)));
#define LAS __attribute__((address_space(3)))

#define XB_TMO      128
#define XB_XCNT(j)  (256  + 64 * (j))
#define XB_XSUB(j)  (1280 + 64 * (j))
#define XB_XGEN(j)  (2304 + 64 * (j))
#define XB_TOP      3328
#define XB_TOPGEN   3392
#define XCD_BAR_WORDS 3456
#define XB_SPIN_CAP (1u << 18)

__device__ __forceinline__ unsigned xb_ld(unsigned* p)              { return __hip_atomic_load(p, __ATOMIC_RELAXED, __HIP_MEMORY_SCOPE_AGENT); }
__device__ __forceinline__ unsigned xb_add(unsigned* p, unsigned v) { return __hip_atomic_fetch_add(p, v, __ATOMIC_RELAXED, __HIP_MEMORY_SCOPE_AGENT); }
__device__ __forceinline__ unsigned xb_xcc_id() { return (unsigned)__builtin_amdgcn_s_getreg((3 << 11) | 20) & 0xFu; }
#define XB_SPIN(cond, bar) do { unsigned _sp = 0; while (cond) { __builtin_amdgcn_s_sleep(1); \
    if ((++_sp & 255u) == 0u) { if (xb_ld(&(bar)[XB_TMO])) break; if (_sp > XB_SPIN_CAP) { atomicAdd(&(bar)[XB_TMO], 1u); break; } } } } while (0)

struct XcdBarrier {
    unsigned* bar; unsigned x;
    volatile LAS unsigned* st;
};

__device__ __forceinline__ XcdBarrier xcd_barrier_post(unsigned* bar, volatile LAS unsigned* st) {
    XcdBarrier b; b.bar = bar; b.x = xb_xcc_id(); b.st = st;
    if (threadIdx.x == 0) (void)xb_add(&bar[XB_XCNT(b.x)], 1u);
    return b;
}
__device__ __forceinline__ void xcd_barrier_complete(unsigned* bar, unsigned x, unsigned& nloc, unsigned& nx) {
    const unsigned G = gridDim.x * gridDim.y * gridDim.z;
    unsigned sum, cnt, mine, sp = 0u;
    for (;;) {
        sum = 0u; cnt = 0u; mine = 0u;
#pragma unroll
        for (unsigned j = 0; j < 16; ++j) { const unsigned c = xb_ld(&bar[XB_XCNT(j)]); sum += c; cnt += (c > 0u) ? 1u : 0u; mine = (j == x) ? c : mine; }
        if (sum == G) break;
        __builtin_amdgcn_s_sleep(1);
        if ((++sp & 255u) == 0u) { if (xb_ld(&bar[XB_TMO])) break; if (sp > XB_SPIN_CAP) { atomicAdd(&bar[XB_TMO], 1u); break; } }
    }
    nloc = mine > 0u ? mine : 1u; nx = cnt > 0u ? cnt : 1u;
}

__device__ __forceinline__ void xcd_barrier(const XcdBarrier& b) {
    asm volatile("s_waitcnt vmcnt(0)" ::: "memory");
    __syncthreads();
    if (threadIdx.x == 0) {
        unsigned* bar = b.bar;
        __builtin_amdgcn_s_waitcnt(0);
        unsigned nloc = b.st[0], nx = b.st[1];
        if (nloc == 0u) { xcd_barrier_complete(bar, b.x, nloc, nx); b.st[0] = nloc; b.st[1] = nx; }
        const unsigned old = xb_add(&bar[XB_XSUB(b.x)], 1u);
        const unsigned gen = old / nloc;
        if (old + 1u == (gen + 1u) * nloc) {
            __builtin_amdgcn_fence(__ATOMIC_RELEASE, "agent");
            asm volatile("s_waitcnt vmcnt(0)" ::: "memory");
            const unsigned og = xb_add(&bar[XB_TOP], 1u);
            const unsigned tg = og / nx;
            if (og + 1u == (tg + 1u) * nx) xb_add(&bar[XB_TOPGEN], 1u);
            else XB_SPIN(xb_ld(&bar[XB_TOPGEN]) == tg, bar);
            __builtin_amdgcn_fence(__ATOMIC_ACQUIRE, "agent");
            xb_add(&bar[XB_XGEN(b.x)], 1u);
            asm volatile("s_waitcnt vmcnt(0)" ::: "memory");
        } else {
            XB_SPIN(xb_ld(&bar[XB_XGEN(b.x)]) == gen, bar);
            __builtin_amdgcn_fence(__ATOMIC_ACQUIRE, "agent");
            asm volatile("s_waitcnt vmcnt(0)" ::: "memory");
        }
    }
    __syncthreads();
}


constexpr int NTHREADS = 512;
constexpr int LDS_BYTES = 147456;
constexpr int M = 16384, DM = 1024, SEQ = 4096, NB = 4;
constexpr int DIN = 3848, NPAD = 4096, PW = 3840;
constexpr float EPS = 1e-6f;
constexpr float LOG2E = 1.4426950408889634f;
constexpr float C2 = 0.125f * LOG2E;

constexpr size_t MiB = 1u << 20;
constexpr size_t WS_WIN = 0;
constexpr size_t WS_WOUT = 16 * MiB;
constexpr size_t WS_SS = 20 * MiB;
constexpr size_t WS_LB = 20 * MiB + 512 * 1024;
constexpr size_t WS_FLOGT = 21 * MiB;
constexpr size_t WS_DD = 22 * MiB;
constexpr size_t WS_CTL = 23 * MiB, CTL_BYTES = 65536;
constexpr size_t WS_U = 24 * MiB;
constexpr size_t WS_XB = 32 * MiB;
constexpr size_t WS_Y = 64 * MiB;
constexpr size_t WS_LOGF = 96 * MiB;
constexpr size_t WS_P = 112 * MiB;
constexpr size_t WS_SB = 232 * MiB;
constexpr int CW_PANEL = 8192;
constexpr int CW_HU = 3584;

struct Args { const float* in[12]; float* out; unsigned char* ws; };

constexpr int CTL_WORDS = 16384, CW_DONE = 16000;
__device__ unsigned g_ctl[CTL_WORDS];

struct Ctx {
    const float *x, *norm_g, *w_in, *w_out, *ln_g, *ln_b, *w_s, *b_s, *hlb, *og, *bf, *gfin;
    float* out;
    bf16_t *WinT, *WoutT, *XB, *Y, *P;
    float *SS, *LB, *FLOGT, *DD, *U, *LOGF;
    bf16_t* SB; unsigned* ctl;
};

DI const void* karg_ptr(int byte_off) {
    const __attribute__((address_space(1))) void* p;
    asm volatile("s_load_dwordx2 %0, %1, %2\n\ts_waitcnt lgkmcnt(0)" : "=s"(p) : "s"(__builtin_amdgcn_kernarg_segment_ptr()), "i"(byte_off) : "memory");
    return (const void*)p;
}
#define KARG(i) karg_ptr((i) * 8)
DI Ctx load_ctx() {
    Ctx c;
    c.x = (const float*)KARG(0); c.norm_g = (const float*)KARG(1); c.w_in = (const float*)KARG(2); c.w_out = (const float*)KARG(3);
    c.ln_g = (const float*)KARG(4); c.ln_b = (const float*)KARG(5); c.w_s = (const float*)KARG(6); c.b_s = (const float*)KARG(7);
    c.hlb = (const float*)KARG(8); c.og = (const float*)KARG(9); c.bf = (const float*)KARG(10); c.gfin = (const float*)KARG(11);
    c.out = (float*)KARG(12);
    unsigned char* ws = (unsigned char*)KARG(13);
    c.WinT = (bf16_t*)(ws + WS_WIN); c.WoutT = (bf16_t*)(ws + WS_WOUT); c.XB = (bf16_t*)(ws + WS_XB); c.Y = (bf16_t*)(ws + WS_Y); c.P = (bf16_t*)(ws + WS_P);
    c.SS = (float*)(ws + WS_SS); c.LB = (float*)(ws + WS_LB); c.FLOGT = (float*)(ws + WS_FLOGT); c.DD = (float*)(ws + WS_DD); c.U = (float*)(ws + WS_U); c.LOGF = (float*)(ws + WS_LOGF);
    c.SB = (bf16_t*)(ws + WS_SB); c.ctl = g_ctl;
    return c;
}

DI int opaque_tid() { int t = threadIdx.x; asm volatile("" : "+v"(t)); return t; }
DI float bf2f(bf16_t b) { return __uint_as_float(((unsigned)b) << 16); }
typedef float f32x2_t __attribute__((ext_vector_type(2)));
typedef __bf16 bf16x2_t __attribute__((ext_vector_type(2)));
DI unsigned pk2(float lo, float hi) { const f32x2_t v = {lo, hi}; const bf16x2_t b = __builtin_convertvector(v, bf16x2_t); return __builtin_bit_cast(unsigned, b); }
DI unsigned f2bf(float f) { return pk2(f, 0.f) & 0xffffu; }
DI float lo_f(unsigned w) { return __uint_as_float(w << 16); }
DI float hi_f(unsigned w) { return __uint_as_float(w & 0xffff0000u); }
DI float wave_sum(float v) {
#pragma unroll
    for (int o = 1; o < 64; o <<= 1) v += __shfl_xor(v, o);
    return v;
}
DI float rcp_(float x) { return __builtin_amdgcn_rcpf(x); }
DI float ex2_(float x) { return __builtin_amdgcn_exp2f(x); }
DI float sigmoidf_(float z) { return rcp_(1.f + ex2_(-LOG2E * z)); }
DI float siluf_(float z) { return z * rcp_(1.f + ex2_(-LOG2E * z)); }
DI float geluf_(float x) { const float u = 0.7978845608028654f * (x + 0.044715f * x * x * x); return x * rcp_(1.f + ex2_(-2.f * LOG2E * u)); }
#define MFMA16(a, b, c) __builtin_amdgcn_mfma_f32_16x16x32_bf16((a), (b), (c), 0, 0, 0)
#define MFMA32(a, b, c) __builtin_amdgcn_mfma_f32_32x32x16_bf16((a), (b), (c), 0, 0, 0)

struct EpiIn {
    static constexpr bool PERM = true, AFTER_DRAIN = false;
    bf16_t* P; float* LOGF; float* FLOGT; const float* ss; const float* lb; const float* bfl;
    DI void operator()(const f32x4 (&acc)[2][2][4][2], const pg8::Unit& u, int wr, int wc, int fr, int fq) const {
        const int pn = u.pn;
        const int rowb = u.pm * 256 + wr * 64 + fr;
        float rsv[2][4];
#pragma unroll
        for (int ai = 0; ai < 2; ++ai)
#pragma unroll
            for (int m = 0; m < 4; ++m) rsv[ai][m] = ss[rowb + ai * 128 + m * 16];
#pragma unroll
        for (int ai = 0; ai < 2; ++ai)
#pragma unroll
            for (int m = 0; m < 4; ++m) rsv[ai][m] = rsqrtf(rsv[ai][m] * (1.f / DM) + EPS);
        if (pn == 15) {
            if (wc == 0 && fq == 0) {
#pragma unroll
                for (int ai = 0; ai < 2; ++ai)
#pragma unroll
                    for (int m = 0; m < 4; ++m) {
                        const int row = rowb + ai * 128 + m * 16;
                        const float rs = rsv[ai][m];
                        const int b = row >> 12, s = row & 4095;
#pragma unroll
                        for (int n = 0; n < 2; ++n)
#pragma unroll
                            for (int i = 0; i < 4; ++i) {
                                const int h = 4 * n + i;
                                const float t = acc[ai][0][m][n][i] * rs + bfl[h];
                                const float ls = fminf(t, 0.f) - log1pf(expf(-fabsf(t)));
                                FLOGT[(size_t)(b * 8 + h) * SEQ + s] = ls * LOG2E;
                            }
                    }
            }
            return;
        }
        int mode = 0; float scale = 1.f;
        if (pn <= 1) mode = 1;
        else if (pn == 2 || pn == 6 || pn >= 13) mode = 2;
        else if (pn == 3) { mode = 2; scale = 0.125f; }
        else if (pn == 4) mode = 3;
        else if (pn == 7 || pn == 8) scale = C2;
        const int cl = wc * 32 + 8 * fq;
#pragma unroll
        for (int ai = 0; ai < 2; ++ai)
#pragma unroll
            for (int m = 0; m < 4; ++m) {
                const int row = rowb + ai * 128 + m * 16;
                const float rs = rsv[ai][m];
#pragma unroll
                for (int bj = 0; bj < 2; ++bj) {
                    const int ct = bj * 128 + cl;
                    float v[8];
#pragma unroll
                    for (int i = 0; i < 4; ++i) { v[i] = acc[ai][bj][m][0][i] * rs; v[4 + i] = acc[ai][bj][m][1][i] * rs; }
                    if (mode == 1) {
#pragma unroll
                        for (int i = 0; i < 8; ++i) v[i] = geluf_(v[i]);
                    } else if (mode == 2) {
#pragma unroll
                        for (int i = 0; i < 8; ++i) v[i] = siluf_(v[i]) * scale;
                    } else if (mode == 3) {
                        float lf[8];
#pragma unroll
                        for (int i = 0; i < 8; ++i) {
                            const float l = lb[ct + i], z = v[i];
                            const float sg = sigmoidf_(z);
                            const float f = l + (1.f - l) * sg;
                            lf[i] = __logf(fmaxf(f, 1e-30f));
                            v[i] = (1.f - l) * sigmoidf_(-z);
                        }
                        float* lp = LOGF + (size_t)row * 256 + ct;
                        *(f32x4*)lp = (f32x4){lf[0], lf[1], lf[2], lf[3]};
                        *(f32x4*)(lp + 4) = (f32x4){lf[4], lf[5], lf[6], lf[7]};
                    } else {
#pragma unroll
                        for (int i = 0; i < 8; ++i) v[i] *= scale;
                    }
                    u32x4 w; w.x = pk2(v[0], v[1]); w.y = pk2(v[2], v[3]); w.z = pk2(v[4], v[5]); w.w = pk2(v[6], v[7]);
                    *(u32x4*)(P + (size_t)row * PW + pn * 256 + ct) = w;
                }
            }
    }
};

struct EpiOut {
    static constexpr bool PERM = true, AFTER_DRAIN = false;
    const float* xin; float* xout; bf16_t* XB; float* ssn;
    DI void operator()(const f32x4 (&acc)[2][2][4][2], const pg8::Unit& u, int wr, int wc, int fr, int fq) const {
        const int rowb = u.pm * 256 + wr * 64 + fr;
        const int cb = u.pn * 256 + wc * 32 + 8 * fq;
#pragma unroll
        for (int ai = 0; ai < 2; ++ai) {
            f32x4 xv[4][2][2];
#pragma unroll
            for (int m = 0; m < 4; ++m)
#pragma unroll
                for (int bj = 0; bj < 2; ++bj) {
                    const size_t o = (size_t)(rowb + ai * 128 + m * 16) * DM + cb + bj * 128;
                    xv[m][bj][0] = *(const f32x4*)(xin + o); xv[m][bj][1] = *(const f32x4*)(xin + o + 4);
                }
#pragma unroll
            for (int m = 0; m < 4; ++m) {
                const int row = rowb + ai * 128 + m * 16;
                float sq = 0.f;
#pragma unroll
                for (int bj = 0; bj < 2; ++bj) {
                    const size_t o = (size_t)row * DM + cb + bj * 128;
                    f32x4 x0 = xv[m][bj][0], x1 = xv[m][bj][1];
                    x0 = x0 + acc[ai][bj][m][0]; x1 = x1 + acc[ai][bj][m][1];
                    __builtin_nontemporal_store(x0, (f32x4*)(xout + o)); __builtin_nontemporal_store(x1, (f32x4*)(xout + o + 4));
                    u32x4 w; w.x = pk2(x0[0], x0[1]); w.y = pk2(x0[2], x0[3]); w.z = pk2(x1[0], x1[1]); w.w = pk2(x1[2], x1[3]);
                    *(u32x4*)(XB + o) = w;
                    sq += x0[0] * x0[0] + x0[1] * x0[1] + x0[2] * x0[2] + x0[3] * x0[3] + x1[0] * x1[0] + x1[1] * x1[1] + x1[2] * x1[2] + x1[3] * x1[3];
                }
                sq += __shfl_xor(sq, 16); sq += __shfl_xor(sq, 32);
                if (fq == 0) atomicAdd(ssn + row, sq);
            }
        }
    }
};

struct EpiOutFinal {
    static constexpr bool PERM = true, AFTER_DRAIN = false;
    const float* xin; float* out; float* ss; unsigned* pcnt; const float* gf;
    DI void operator()(const f32x4 (&acc_)[2][2][4][2], const pg8::Unit& u, int wr, int wc, int fr, int fq) const {
        f32x4 (&acc)[2][2][4][2] = const_cast<f32x4 (&)[2][2][4][2]>(acc_);
        const int rowb = u.pm * 256 + wr * 64 + fr;
        const int cb = u.pn * 256 + wc * 32 + 8 * fq;
#pragma unroll
        for (int ai = 0; ai < 2; ++ai)
#pragma unroll
            for (int m = 0; m < 4; ++m) {
                const int row = rowb + ai * 128 + m * 16;
                float sq = 0.f;
#pragma unroll
                for (int bj = 0; bj < 2; ++bj) {
                    const size_t o = (size_t)row * DM + cb + bj * 128;
                    const f32x4 x0 = *(const f32x4*)(xin + o) + acc[ai][bj][m][0], x1 = *(const f32x4*)(xin + o + 4) + acc[ai][bj][m][1];
                    acc[ai][bj][m][0] = x0; acc[ai][bj][m][1] = x1;
                    sq += x0[0] * x0[0] + x0[1] * x0[1] + x0[2] * x0[2] + x0[3] * x0[3] + x1[0] * x1[0] + x1[1] * x1[1] + x1[2] * x1[2] + x1[3] * x1[3];
                }
                sq += __shfl_xor(sq, 16); sq += __shfl_xor(sq, 32);
                if (fq == 0) atomicAdd(ss + row, sq);
            }
        asm volatile("s_waitcnt vmcnt(0)" ::: "memory");
        __syncthreads();
        if (threadIdx.x == 0) {
            __builtin_amdgcn_fence(__ATOMIC_RELEASE, "agent"); asm volatile("s_waitcnt vmcnt(0)" ::: "memory");
            unsigned* pc = pcnt + 64 * u.pm;
            xb_add(pc, 1u);
            unsigned sp = 0;
            while (xb_ld(pc) < 4u) { __builtin_amdgcn_s_sleep(1); if (++sp > (1u << 22)) break; }
            __builtin_amdgcn_fence(__ATOMIC_ACQUIRE, "agent"); asm volatile("s_waitcnt vmcnt(0)" ::: "memory");
        }
        __syncthreads();
#pragma unroll
        for (int ai = 0; ai < 2; ++ai)
#pragma unroll
            for (int m = 0; m < 4; ++m) {
                const int row = rowb + ai * 128 + m * 16;
                const float rs = rsqrtf(__hip_atomic_load(ss + row, __ATOMIC_RELAXED, __HIP_MEMORY_SCOPE_AGENT) * (1.f / DM) + EPS);
#pragma unroll
                for (int bj = 0; bj < 2; ++bj) {
                    const int col = cb + bj * 128;
                    const f32x4 g0 = *(const f32x4*)(gf + col), g1 = *(const f32x4*)(gf + col + 4);
                    const size_t o = (size_t)row * DM + col;
                    __builtin_nontemporal_store(acc[ai][bj][m][0] * rs * g0, (f32x4*)(out + o)); __builtin_nontemporal_store(acc[ai][bj][m][1] * rs * g1, (f32x4*)(out + o + 4));
                }
            }
    }
};

DI void transpose_item(const float* W, int N, bf16_t* WT, const float* g, int kb, int nb, float* scr, int lane) {
    const int k0 = 64 * kb, n0 = 64 * nb;
    const bool nok = (n0 + lane) < N;
    float v[64];
#pragma unroll
    for (int i = 0; i < 64; ++i) v[i] = nok ? W[(size_t)(k0 + i) * N + n0 + lane] : 0.f;
    if (g) {
#pragma unroll
        for (int i = 0; i < 64; ++i) v[i] *= g[k0 + i];
    }
#pragma unroll
    for (int i = 0; i < 64; ++i) scr[i * 65 + lane] = v[i];
    asm volatile("s_waitcnt lgkmcnt(0)" ::: "memory");
    const int cch = lane & 7;
#pragma unroll
    for (int j = 0; j < 8; ++j) {
        const int n = (lane >> 3) + 8 * j;
        const float* sp = scr + (8 * cch) * 65 + n;
        u32x4 o; o.x = pk2(sp[0], sp[65]); o.y = pk2(sp[2 * 65], sp[3 * 65]); o.z = pk2(sp[4 * 65], sp[5 * 65]); o.w = pk2(sp[6 * 65], sp[7 * 65]);
        if (n0 + n < N) *(u32x4*)(WT + (size_t)(n0 + n) * 1024 + k0 + 8 * cch) = o;
    }
    asm volatile("s_waitcnt lgkmcnt(0)" ::: "memory");
}

DI void prologue(const Ctx& c, int vcu, int G, unsigned char* lds) {
    const int tid = opaque_tid(), lane = tid & 63, wave = tid >> 6;
    const int gw = vcu * 8 + wave, NGW = G * 8;
    float* scr = (float*)lds + wave * (64 * 65);
#pragma unroll 8
    for (int r = vcu * 8 + wave; r < M; r += G * 8) {
        const f32x4* xr = (const f32x4*)(c.x + (size_t)r * DM) + lane;
        u32x2* o8 = (u32x2*)(c.XB + (size_t)r * DM) + lane;
        float s = 0.f;
#pragma unroll
        for (int j = 0; j < 4; ++j) { const f32x4 v = xr[64 * j]; s += v[0] * v[0] + v[1] * v[1] + v[2] * v[2] + v[3] * v[3];
            o8[64 * j] = (u32x2){pk2(v[0], v[1]), pk2(v[2], v[3])}; }
        s = wave_sum(s);
        if (lane == 0) c.SS[r] = s;
    }
    constexpr int NB_IN = (DIN + 63) / 64, IT_IN = 16 * NB_IN, IT_OUT = 16 * 16;
    for (int it = gw; it < 2 * IT_IN + 2 * IT_OUT; it += NGW) {
        int r = it;
        if (r < 2 * IT_IN) { const int L = r / IT_IN; r -= L * IT_IN;
            transpose_item(c.w_in + (size_t)L * 1024 * DIN, DIN, c.WinT + (size_t)L * NPAD * 1024, c.norm_g + L * 1024, r / NB_IN, r % NB_IN, scr, lane); }
        else { r -= 2 * IT_IN; const int L = r / IT_OUT; r -= L * IT_OUT;
            transpose_item(c.w_out + (size_t)L * 1024 * 1024, 1024, c.WoutT + (size_t)L * 1024 * 1024, nullptr, r / 16, r % 16, scr, lane); }
    }
    for (int i = vcu * NTHREADS + tid; i < 2 * 248 * 128; i += G * NTHREADS) {
        const int L = i / (248 * 128), r = i % (248 * 128);
        *(u32x4*)(c.WinT + (size_t)L * NPAD * 1024 + (size_t)(DIN + r / 128) * 1024 + (r % 128) * 8) = (u32x4){0u, 0u, 0u, 0u};
    }
    for (int i = vcu * NTHREADS + tid; i < 2 * M; i += G * NTHREADS) c.SS[M + i] = 0.f;
    for (int i = vcu * NTHREADS + tid; i < 256; i += G * NTHREADS) {
        const float l0 = c.hlb[i], l1 = c.hlb[256 + i], mx = fmaxf(l0, l1);
        const float e0 = expf(l0 - mx), e1 = expf(l1 - mx);
        const float p0 = e0 / (e0 + e1), p1 = e1 / (e0 + e1);
        c.LB[i] = fminf(fmaxf(p0 - p0, 0.f), 1.f - 1e-6f);
        c.LB[256 + i] = fminf(fmaxf((p0 + p1) - p0, 0.f), 1.f - 1e-6f);
    }
}

DI void hgrn_cumsum(const float* LOGF, size_t row0, int h, float* segtot, float (&bl)[16], float& tot) {
    const int tid = opaque_tid(), k = tid & 63, seg = tid >> 6;
    const float* lf = LOGF + (row0 + seg * 16) * 256 + h * 64 + k;
    float run = 0.f;
#pragma unroll
    for (int i = 0; i < 16; ++i) { run += lf[(size_t)i * 256]; bl[i] = run; }
    segtot[seg * 64 + k] = run;
    __syncthreads();
    float off = 0.f; tot = 0.f;
#pragma unroll
    for (int s2 = 0; s2 < 8; ++s2) { const float v = segtot[s2 * 64 + k]; if (s2 < seg) off += v; tot += v; }
#pragma unroll
    for (int i = 0; i < 16; ++i) bl[i] += off;
}
DI void stage_colT(const bf16_t* P, size_t row0, int colbase, bf16_t* img) {
    const int tid = opaque_tid(), k = tid & 63, seg = tid >> 6;
    const bf16_t* p = P + (row0 + seg * 16) * PW + colbase + k;
    unsigned w[8];
#pragma unroll
    for (int i = 0; i < 8; ++i) w[i] = (unsigned)p[(size_t)(2 * i) * PW] | ((unsigned)p[(size_t)(2 * i + 1) * PW] << 16);
    u32x4* d = (u32x4*)(img + k * 136 + seg * 16);
    d[0] = (u32x4){w[0], w[1], w[2], w[3]}; d[1] = (u32x4){w[4], w[5], w[6], w[7]};
}

DI void hgrn_u_pair(const Ctx& c, int itA, int itB, unsigned char* lds, unsigned* cnt) {
    const int tid = opaque_tid(), lane = tid & 63, wave = tid >> 6, fr = lane & 15, fq = lane >> 4;
    const int k = tid & 63, seg = tid >> 6;
    const int items[2] = {itA, itB >= 0 ? itB : itA};
    constexpr int ISZ = 64 * 136 * 2 * 2 + 2048;
    float bl[2][16]; unsigned short kr[2][16];
    size_t row0[2]; int hh[2];
#pragma unroll
    for (int u = 0; u < 2; ++u) {
        const int item = items[u], b = item >> 7, h = (item >> 5) & 3, ch = item & 31;
        hh[u] = h; row0[u] = (size_t)b * SEQ + ch * 128;
        const float* lf = c.LOGF + (row0[u] + seg * 16) * 256 + h * 64 + k;
        const bf16_t* kp = c.P + (row0[u] + seg * 16) * PW + 1024 + h * 64 + k;
#pragma unroll
        for (int i = 0; i < 16; ++i) { bl[u][i] = lf[(size_t)i * 256]; kr[u][i] = kp[(size_t)i * PW]; }
    }
#pragma unroll
    for (int u = 0; u < 2; ++u) stage_colT(c.P, row0[u], 1280 + hh[u] * 64, (bf16_t*)(lds + u * ISZ) + 64 * 136);
#pragma unroll
    for (int u = 0; u < 2; ++u) {
        float* segtot = (float*)(lds + u * ISZ + 64 * 136 * 4);
        float run = 0.f;
#pragma unroll
        for (int i = 0; i < 16; ++i) { run += bl[u][i]; bl[u][i] = run; }
        segtot[seg * 64 + k] = run;
    }
    __syncthreads();
#pragma unroll
    for (int u = 0; u < 2; ++u) {
        const float* segtot = (const float*)(lds + u * ISZ + 64 * 136 * 4);
        bf16_t* kdT = (bf16_t*)(lds + u * ISZ);
        float off = 0.f, tot = 0.f;
#pragma unroll
        for (int s2 = 0; s2 < 8; ++s2) { const float v = segtot[s2 * 64 + k]; if (s2 < seg) off += v; tot += v; }
        const float tb = tot - off;
        unsigned w[8];
#pragma unroll
        for (int i = 0; i < 8; ++i)
            w[i] = pk2(bf2f(kr[u][2 * i]) * __expf(tb - bl[u][2 * i]), bf2f(kr[u][2 * i + 1]) * __expf(tb - bl[u][2 * i + 1]));
        u32x4* d = (u32x4*)(kdT + k * 136 + seg * 16);
        d[0] = (u32x4){w[0], w[1], w[2], w[3]}; d[1] = (u32x4){w[4], w[5], w[6], w[7]};
        if (seg == 0) c.DD[(size_t)items[u] * 64 + k] = __expf(tot);
    }
    __syncthreads();
    const int mt = wave >> 1, nt0 = (wave & 1) * 2;
#pragma unroll
    for (int u = 0; u < 2; ++u) {
        const bf16_t* kdT = (const bf16_t*)(lds + u * ISZ);
        const bf16_t* vT = kdT + 64 * 136;
        f32x4 acc[2] = {(f32x4){0.f, 0.f, 0.f, 0.f}, (f32x4){0.f, 0.f, 0.f, 0.f}};
#pragma unroll
        for (int ks = 0; ks < 4; ++ks) {
            const bf16x8 A = *(const bf16x8*)(kdT + (mt * 16 + fr) * 136 + ks * 32 + fq * 8);
#pragma unroll
            for (int n2 = 0; n2 < 2; ++n2) {
                const bf16x8 B = *(const bf16x8*)(vT + ((nt0 + n2) * 16 + fr) * 136 + ks * 32 + fq * 8);
                acc[n2] = MFMA16(A, B, acc[n2]);
            }
        }
        float* Up = c.U + (size_t)items[u] * 4096;
#pragma unroll
        for (int n2 = 0; n2 < 2; ++n2) *(f32x4*)(Up + ((nt0 + n2) * 16 + fr) * 64 + mt * 16 + fq * 4) = acc[n2];
    }
    asm volatile("s_waitcnt vmcnt(0)" ::: "memory");
    __syncthreads();
    if (tid == 0) { __builtin_amdgcn_fence(__ATOMIC_RELEASE, "agent"); asm volatile("s_waitcnt vmcnt(0)" ::: "memory"); xb_add(cnt, itB >= 0 ? 2u : 1u); }
}

DI void gmlp_pair(const Ctx& c, int L, int itA, int itB, unsigned char* lds) {
    const int tid = opaque_tid(), lane = tid & 63, wave = tid >> 6, fr = lane & 15, fq = lane >> 4;
    const int items[2] = {itA, itB >= 0 ? itB : itA};
    constexpr int VS = 136;
    size_t row0[2]; int gg[2];
    u32x4 w0[2], w1[2];
#pragma unroll
    for (int u = 0; u < 2; ++u) {
        const int item = items[u], b = item >> 7, n = (item >> 2) & 31, g = item & 3;
        gg[u] = g; row0[u] = (size_t)b * SEQ + n * 128;
        const bf16_t* src = c.P + (row0[u] + (tid >> 2)) * PW + 256 + g * 64 + (tid & 3) * 16;
        w0[u] = *(const u32x4*)src; w1[u] = *(const u32x4*)(src + 8);
    }
    unsigned short gur[2][4][4], szr[2][4][4];
#pragma unroll
    for (int u = 0; u < 2; ++u)
#pragma unroll
        for (int nt = 0; nt < 4; ++nt)
#pragma unroll
            for (int reg = 0; reg < 4; ++reg) {
                const size_t row = row0[u] + wave * 16 + fq * 4 + reg; const int cc = gg[u] * 64 + nt * 16 + fr;
                gur[u][nt][reg] = c.P[row * PW + cc]; szr[u][nt][reg] = c.P[row * PW + 512 + cc];
            }
#pragma unroll
    for (int u = 0; u < 2; ++u) {
        bf16_t* vnT = (bf16_t*)lds + u * 64 * VS;
        const int s = tid >> 2, part = tid & 3, g = gg[u];
        float x[16];
#pragma unroll
        for (int i = 0; i < 4; ++i) { x[2 * i] = lo_f(w0[u][i]); x[2 * i + 1] = hi_f(w0[u][i]); x[8 + 2 * i] = lo_f(w1[u][i]); x[8 + 2 * i + 1] = hi_f(w1[u][i]); }
        float sum = 0.f;
#pragma unroll
        for (int i = 0; i < 16; ++i) sum += x[i];
        sum += __shfl_xor(sum, 1); sum += __shfl_xor(sum, 2);
        const float mean = sum * (1.f / 64.f);
        float sq = 0.f;
#pragma unroll
        for (int i = 0; i < 16; ++i) { x[i] -= mean; sq += x[i] * x[i]; }
        sq += __shfl_xor(sq, 1); sq += __shfl_xor(sq, 2);
        const float rstd = rsqrtf(sq * (1.f / 64.f) + EPS);
        const float* lg = c.ln_g + L * 256 + g * 64 + part * 16;
        const float* lbp = c.ln_b + L * 256 + g * 64 + part * 16;
#pragma unroll
        for (int i = 0; i < 16; ++i) vnT[(part * 16 + i) * VS + s] = (bf16_t)f2bf(x[i] * rstd * lg[i] + lbp[i]);
    }
    __syncthreads();
    const int t = wave * 16 + fr;
    const int ksmax = (wave * 16 + 15) >> 5;
#pragma unroll
    for (int u = 0; u < 2; ++u) {
        const bf16_t* vnT = (const bf16_t*)lds + u * 64 * VS;
        const int g = gg[u];
        f32x4 acc[4];
#pragma unroll
        for (int i = 0; i < 4; ++i) acc[i] = (f32x4){0.f, 0.f, 0.f, 0.f};
        const float* wrow = c.w_s + ((size_t)(L * 4 + g) * 128 + t) * 128;
        for (int ks = 0; ks <= ksmax; ++ks) {
            const int s0 = ks * 32 + fq * 8;
            const f32x4 wa = *(const f32x4*)(wrow + s0), wb = *(const f32x4*)(wrow + s0 + 4);
            float wv[8] = {wa[0], wa[1], wa[2], wa[3], wb[0], wb[1], wb[2], wb[3]};
#pragma unroll
            for (int j = 0; j < 8; ++j) if (s0 + j > t) wv[j] = 0.f;
            u32x4 aw; aw.x = pk2(wv[0], wv[1]); aw.y = pk2(wv[2], wv[3]); aw.z = pk2(wv[4], wv[5]); aw.w = pk2(wv[6], wv[7]);
            const bf16x8 A = __builtin_bit_cast(bf16x8, aw);
#pragma unroll
            for (int nt = 0; nt < 4; ++nt) {
                const bf16x8 B = *(const bf16x8*)(vnT + (nt * 16 + fr) * VS + s0);
                acc[nt] = MFMA16(A, B, acc[nt]);
            }
        }
        const float* bsp = c.b_s + (size_t)(L * 4 + g) * 128 + wave * 16 + fq * 4;
#pragma unroll
        for (int nt = 0; nt < 4; ++nt) {
            const int cc = g * 64 + nt * 16 + fr;
#pragma unroll
            for (int reg = 0; reg < 4; ++reg) {
                const size_t row = row0[u] + wave * 16 + fq * 4 + reg;
                const float mixed = acc[nt][reg] + bsp[reg];
                c.Y[row * DM + cc] = (bf16_t)f2bf(bf2f(gur[u][nt][reg]) * mixed * bf2f(szr[u][nt][reg]));
            }
        }
    }
    __syncthreads();
}

DI void hgrn_scan_item(const Ctx& c, int item, unsigned* cnt) {
    const int tid = opaque_tid();
    if (tid == 0) {
        unsigned sp = 0;
        while (xb_ld(cnt) < 512u) { __builtin_amdgcn_s_sleep(1); if (++sp > (1u << 22)) break; }
        __builtin_amdgcn_fence(__ATOMIC_ACQUIRE, "agent");
        asm volatile("s_waitcnt vmcnt(0)" ::: "memory");
    }
    __syncthreads();
    const int bhh = item >> 1, vh = item & 1;
    const int v = vh * 32 + (tid >> 4), k4 = (tid & 15) * 4;
    const float* Ub = c.U + (size_t)bhh * 32 * 4096 + v * 64 + k4;
    const float* Db = c.DD + (size_t)bhh * 32 * 64 + k4;
    bf16_t* Sb = c.SB + (size_t)bhh * 32 * 4096 + v * 64 + k4;
    f32x4 S = (f32x4){0.f, 0.f, 0.f, 0.f};
    for (int j0 = 0; j0 < 32; j0 += 8) {
        f32x4 u[8], d[8];
#pragma unroll
        for (int j = 0; j < 8; ++j) { u[j] = *(const f32x4*)(Ub + (size_t)(j0 + j) * 4096); d[j] = *(const f32x4*)(Db + (size_t)(j0 + j) * 64); }
#pragma unroll
        for (int j = 0; j < 8; ++j) {
            *(u32x2*)(Sb + (size_t)(j0 + j) * 4096) = (u32x2){pk2(S[0], S[1]), pk2(S[2], S[3])};
            S = d[j] * S + u[j];
        }
    }
}

DI void hgrn_o_item(const Ctx& c, int L, int item, unsigned char* lds) {
    const int tid = opaque_tid(), lane = tid & 63, wave = tid >> 6, fr = lane & 15, fq = lane >> 4;
    const int b = item >> 7, h = (item >> 5) & 3, ch = item & 31;
    const size_t row0 = (size_t)b * SEQ + ch * 128;
    bf16_t* qs = (bf16_t*)lds;
    bf16_t* ks_ = qs + 128 * 72;
    float* bs = (float*)(ks_ + 128 * 72);
    bf16_t* vT = (bf16_t*)(bs + 128 * 68);
    bf16_t* ST = vT + 64 * 136;
    bf16_t* Ab = ST + 64 * 72;
    float* segtot = (float*)(Ab + 8 * 16 * 136);
    const int k = tid & 63, seg = tid >> 6;
    const u32x4 sbv = *(const u32x4*)(c.SB + (size_t)item * 4096 + (tid >> 3) * 64 + (tid & 7) * 8);
    float bl[16]; unsigned short vr[16];
    {
        const float* lf = c.LOGF + (row0 + seg * 16) * 256 + h * 64 + k;
        const bf16_t* vp = c.P + (row0 + seg * 16) * PW + 1280 + h * 64 + k;
#pragma unroll
        for (int i = 0; i < 16; ++i) { bl[i] = lf[(size_t)i * 256]; vr[i] = vp[(size_t)i * PW]; }
    }
    u32x4 qv[2], kv[2];
#pragma unroll
    for (int i = 0; i < 2; ++i) {
        const int id = tid + 512 * i, t = id >> 3, cc = id & 7;
        qv[i] = *(const u32x4*)(c.P + (row0 + t) * PW + 768 + h * 64 + cc * 8);
        kv[i] = *(const u32x4*)(c.P + (row0 + t) * PW + 1024 + h * 64 + cc * 8);
    }
    unsigned short zg[4][4];
#pragma unroll
    for (int nt = 0; nt < 4; ++nt)
#pragma unroll
        for (int reg = 0; reg < 4; ++reg) zg[nt][reg] = c.P[(row0 + wave * 16 + 4 * fq + reg) * PW + 1536 + h * 64 + nt * 16 + fr];
    *(u32x4*)(ST + (tid >> 3) * 72 + (tid & 7) * 8) = sbv;
#pragma unroll
    for (int i = 0; i < 2; ++i) {
        const int id = tid + 512 * i, t = id >> 3, cc = id & 7;
        *(u32x4*)(qs + t * 72 + cc * 8) = qv[i];
        *(u32x4*)(ks_ + t * 72 + cc * 8) = kv[i];
    }
    {
        u32x4* d = (u32x4*)(vT + k * 136 + seg * 16);
        d[0] = (u32x4){(unsigned)vr[0] | ((unsigned)vr[1] << 16), (unsigned)vr[2] | ((unsigned)vr[3] << 16), (unsigned)vr[4] | ((unsigned)vr[5] << 16), (unsigned)vr[6] | ((unsigned)vr[7] << 16)};
        d[1] = (u32x4){(unsigned)vr[8] | ((unsigned)vr[9] << 16), (unsigned)vr[10] | ((unsigned)vr[11] << 16), (unsigned)vr[12] | ((unsigned)vr[13] << 16), (unsigned)vr[14] | ((unsigned)vr[15] << 16)};
    }
    {
        float run = 0.f;
#pragma unroll
        for (int i = 0; i < 16; ++i) { run += bl[i]; bl[i] = run; }
        segtot[seg * 64 + k] = run;
    }
    __syncthreads();
    {
        float off = 0.f;
#pragma unroll
        for (int s2 = 0; s2 < 8; ++s2) { const float v = segtot[s2 * 64 + k]; if (s2 < seg) off += v; }
#pragma unroll
        for (int i = 0; i < 16; ++i) bs[(seg * 16 + i) * 68 + k] = bl[i] + off;
    }
    __syncthreads();
    const int w = wave;
    const float* brow = bs + (w * 16 + fr) * 68;
    const float* rho = bs + (w * 16) * 68;
    bf16x8 Aq[2], Aqs[2];
#pragma unroll
    for (int k2 = 0; k2 < 2; ++k2) {
        const int k0 = k2 * 32 + fq * 8;
        const u32x4 qw = *(const u32x4*)(qs + (w * 16 + fr) * 72 + k0);
        const f32x4 b0 = *(const f32x4*)(brow + k0), b1 = *(const f32x4*)(brow + k0 + 4);
        const f32x4 r0 = *(const f32x4*)(rho + k0), r1 = *(const f32x4*)(rho + k0 + 4);
        float q[8] = {lo_f(qw[0]), hi_f(qw[0]), lo_f(qw[1]), hi_f(qw[1]), lo_f(qw[2]), hi_f(qw[2]), lo_f(qw[3]), hi_f(qw[3])};
        float bb[8] = {b0[0], b0[1], b0[2], b0[3], b1[0], b1[1], b1[2], b1[3]};
        float rr[8] = {r0[0], r0[1], r0[2], r0[3], r1[0], r1[1], r1[2], r1[3]};
        u32x4 a, as;
#pragma unroll
        for (int j = 0; j < 4; ++j) {
            a[j] = pk2(q[2 * j] * __expf(bb[2 * j] - rr[2 * j]), q[2 * j + 1] * __expf(bb[2 * j + 1] - rr[2 * j + 1]));
            as[j] = pk2(q[2 * j] * __expf(bb[2 * j]), q[2 * j + 1] * __expf(bb[2 * j + 1]));
        }
        Aq[k2] = __builtin_bit_cast(bf16x8, a); Aqs[k2] = __builtin_bit_cast(bf16x8, as);
    }
    bf16_t* Aw = Ab + w * 16 * 136;
    for (int J = 0; J <= w; ++J) {
        f32x4 sc = (f32x4){0.f, 0.f, 0.f, 0.f};
#pragma unroll
        for (int k2 = 0; k2 < 2; ++k2) {
            const int k0 = k2 * 32 + fq * 8;
            const u32x4 kw = *(const u32x4*)(ks_ + (J * 16 + fr) * 72 + k0);
            const float* bk = bs + (J * 16 + fr) * 68 + k0;
            const f32x4 b0 = *(const f32x4*)bk, b1 = *(const f32x4*)(bk + 4);
            const f32x4 r0 = *(const f32x4*)(rho + k0), r1 = *(const f32x4*)(rho + k0 + 4);
            float kk[8] = {lo_f(kw[0]), hi_f(kw[0]), lo_f(kw[1]), hi_f(kw[1]), lo_f(kw[2]), hi_f(kw[2]), lo_f(kw[3]), hi_f(kw[3])};
            float bb[8] = {b0[0], b0[1], b0[2], b0[3], b1[0], b1[1], b1[2], b1[3]};
            float rr[8] = {r0[0], r0[1], r0[2], r0[3], r1[0], r1[1], r1[2], r1[3]};
            u32x4 bw;
#pragma unroll
            for (int j = 0; j < 4; ++j)
                bw[j] = pk2(kk[2 * j] * __expf(fminf(rr[2 * j] - bb[2 * j], 80.f)), kk[2 * j + 1] * __expf(fminf(rr[2 * j + 1] - bb[2 * j + 1], 80.f)));
            sc = MFMA16(Aq[k2], __builtin_bit_cast(bf16x8, bw), sc);
        }
#pragma unroll
        for (int reg = 0; reg < 4; ++reg) {
            const int tl = 4 * fq + reg;
            float val = sc[reg];
            if (J == w && fr > tl) val = 0.f;
            Aw[tl * 136 + J * 16 + fr] = (bf16_t)f2bf(val);
        }
    }
    if ((w & 1) == 0) {
#pragma unroll
        for (int reg = 0; reg < 4; ++reg) Aw[(4 * fq + reg) * 136 + (w + 1) * 16 + fr] = (bf16_t)0;
    }
    asm volatile("s_waitcnt lgkmcnt(0)" ::: "memory");
    f32x4 o[4];
#pragma unroll
    for (int i = 0; i < 4; ++i) o[i] = (f32x4){0.f, 0.f, 0.f, 0.f};
    const int nks = (16 * (w + 1) + 31) >> 5;
    for (int k2 = 0; k2 < nks; ++k2) {
        const bf16x8 A = *(const bf16x8*)(Aw + fr * 136 + k2 * 32 + fq * 8);
#pragma unroll
        for (int nt = 0; nt < 4; ++nt) {
            const bf16x8 B = *(const bf16x8*)(vT + (nt * 16 + fr) * 136 + k2 * 32 + fq * 8);
            o[nt] = MFMA16(A, B, o[nt]);
        }
    }
#pragma unroll
    for (int k2 = 0; k2 < 2; ++k2)
#pragma unroll
        for (int nt = 0; nt < 4; ++nt) {
            const bf16x8 B = *(const bf16x8*)(ST + (nt * 16 + fr) * 72 + k2 * 32 + fq * 8);
            o[nt] = MFMA16(Aqs[k2], B, o[nt]);
        }
    const float* ogp = c.og + L * 64;
#pragma unroll
    for (int reg = 0; reg < 4; ++reg) {
        float ssq = 0.f;
#pragma unroll
        for (int nt = 0; nt < 4; ++nt) ssq += o[nt][reg] * o[nt][reg];
        ssq += __shfl_xor(ssq, 1); ssq += __shfl_xor(ssq, 2); ssq += __shfl_xor(ssq, 4); ssq += __shfl_xor(ssq, 8);
        const float rinv = rsqrtf(ssq * (1.f / 64.f) + EPS);
        const size_t row = row0 + w * 16 + 4 * fq + reg;
#pragma unroll
        for (int nt = 0; nt < 4; ++nt) {
            const int v = nt * 16 + fr;
            const float y = o[nt][reg] * rinv * ogp[v] * bf2f(zg[nt][reg]);
            c.Y[row * DM + 256 + h * 64 + v] = (bf16_t)f2bf(y);
        }
    }
    __syncthreads();
}

DI int crow(int r, int hi) { return (r & 3) + 8 * (r >> 2) + 4 * hi; }
#define MX3(a, b, c) __builtin_fmaxf(__builtin_fmaxf((a), (b)), (c))
template <int ABL> DI f32x16 mm32(bf16x8 a, bf16x8 b, f32x16 c) {
    if constexpr (ABL == 1) { asm volatile("" :: "v"(a), "v"(b)); return c; } else return MFMA32(a, b, c);
}
template <int ABL> DI void fox_unit(const Ctx& c, int bh, int qb, unsigned char* lds) {
    const int tid = opaque_tid(), lane = tid & 63, wave = tid >> 6, r32 = lane & 31, hi = lane >> 5;
    const int b = bh >> 3, h = bh & 7;
    const size_t rowb = (size_t)b * SEQ;
    float* cL = (float*)lds;
    unsigned char* Kt = lds + 16384;
    unsigned char* Vt = lds + 16384 + 32768;
    float* wtot = (float*)(lds + 16384 + 32768 + 49152);
    const int nkeys = 256 * (qb + 1), NI = 2 * (qb + 1);
    f32x4 fl0 = (f32x4){0.f, 0.f, 0.f, 0.f}, fl1 = fl0;
    if (8 * tid < nkeys) { const f32x4* src = (const f32x4*)(c.FLOGT + (size_t)bh * SEQ + 8 * tid); fl0 = src[0]; fl1 = src[1]; }
    const int qrel = wave * 32 + r32;
    const size_t qrow = rowb + 256 * qb + qrel;
    bf16x8 qr[4];
#pragma unroll
    for (int ks = 0; ks < 4; ++ks) qr[ks] = *(const bf16x8*)(c.P + qrow * PW + 1792 + h * 64 + ks * 16 + hi * 8);
    const int skv = tid >> 3, sch = tid & 7;
    const bf16_t* kg = c.P + (rowb + skv) * PW + 2304 + h * 64 + sch * 8;
    const bf16_t* vg = c.P + (rowb + skv) * PW + 2816 + h * 64 + sch * 8;
    const int kst = skv * 128 + ((sch ^ ((skv >> 1) & 7)) * 16), vst = skv * 192 + sch * 16;
    u32x4 kreg0 = *(const u32x4*)kg, kreg1 = *(const u32x4*)(kg + (size_t)64 * PW), vreg0 = *(const u32x4*)vg, vreg1 = *(const u32x4*)(vg + (size_t)64 * PW);
    {
        float v[8]; float run = 0.f;
        if (8 * tid < nkeys) {
            const float t8[8] = {fl0[0], fl0[1], fl0[2], fl0[3], fl1[0], fl1[1], fl1[2], fl1[3]};
#pragma unroll
            for (int i = 0; i < 8; ++i) { run += t8[i]; v[i] = run; }
        } else {
#pragma unroll
            for (int i = 0; i < 8; ++i) v[i] = 0.f;
        }
        float inc = run;
#pragma unroll
        for (int o = 1; o < 64; o <<= 1) { const float t = __shfl_up(inc, o); if (lane >= o) inc += t; }
        if (lane == 63) wtot[wave] = inc;
        __syncthreads();
        float off = inc - run;
        for (int w2 = 0; w2 < wave; ++w2) off += wtot[w2];
        if (8 * tid < nkeys) {
            *(f32x4*)(cL + 8 * tid) = (f32x4){-(v[0] + off), -(v[1] + off), -(v[2] + off), -(v[3] + off)};
            *(f32x4*)(cL + 8 * tid + 4) = (f32x4){-(v[4] + off), -(v[5] + off), -(v[6] + off), -(v[7] + off)};
        }
    }
    *(u32x4*)(Kt + kst) = kreg0; *(u32x4*)(Kt + kst + 64 * 128) = kreg1; *(u32x4*)(Vt + vst) = vreg0; *(u32x4*)(Vt + vst + 64 * 192) = vreg1;
    __syncthreads();
    const float cq = -cL[256 * qb + qrel];
    float m_run = -1e30f, l_run = 0.f;
    f32x16 o0, o1;
#pragma unroll
    for (int i = 0; i < 16; ++i) { o0[i] = 0.f; o1[i] = 0.f; }
    const int vtr_base = (4 * hi + ((lane & 15) >> 2)) * 192 + (((lane >> 4) & 1) * 16 + (lane & 3) * 4) * 2;
    const int kfr_base = r32 * 128;
    int kch[4];
#pragma unroll
    for (int ks = 0; ks < 4; ++ks) kch[ks] = kfr_base + (((2 * ks + hi) ^ ((r32 >> 1) & 7)) * 16);
    asm volatile("" :: "v"(qr[0]), "v"(qr[1]), "v"(qr[2]), "v"(qr[3]));
    auto step = [&](int it, auto band_tag) __attribute__((always_inline)) {
        constexpr bool BAND = decltype(band_tag)::value;
        const int buf = it & 1;
        if (it + 1 < NI) {
            const size_t go = (size_t)(it + 1) * 128 * PW;
            kreg0 = *(const u32x4*)(kg + go); kreg1 = *(const u32x4*)(kg + go + (size_t)64 * PW); vreg0 = *(const u32x4*)(vg + go); vreg1 = *(const u32x4*)(vg + go + (size_t)64 * PW);
        }
        const int bandi = it - (NI - 2);
        const bool needA = !BAND || (128 * bandi <= 32 * wave + 31);
        const bool needB = !BAND || (128 * bandi + 64 <= 32 * wave + 31);
        if (needA) {
            const unsigned char* Kb = Kt + buf * 16384;
            const unsigned char* Vb = Vt + buf * 24576;
            f32x16 pa0, pa1, pb0, pb1;
            {
                const float* ct = cL + 128 * it + 4 * hi;
#pragma unroll
                for (int g4 = 0; g4 < 4; ++g4) {
                    f32x4 c0, c1, c2, c3; if constexpr (ABL == 2) { c0 = c1 = c2 = c3 = (f32x4){cq, cq, cq, cq}; } else { c0 = *(const f32x4*)(ct + 8 * g4); c1 = *(const f32x4*)(ct + 32 + 8 * g4); c2 = *(const f32x4*)(ct + 64 + 8 * g4); c3 = *(const f32x4*)(ct + 96 + 8 * g4); }
#pragma unroll
                    for (int i = 0; i < 4; ++i) { pa0[4 * g4 + i] = c0[i]; pa1[4 * g4 + i] = c1[i]; pb0[4 * g4 + i] = c2[i]; pb1[4 * g4 + i] = c3[i]; }
                }
            }
#pragma unroll
            for (int ks = 0; ks < 4; ++ks) {
                const bf16x8 k0 = (ABL == 2) ? qr[ks] : *(const bf16x8*)(Kb + kch[ks]);
                const bf16x8 k1 = (ABL == 2) ? qr[ks] : *(const bf16x8*)(Kb + kch[ks] + 32 * 128);
                pa0 = mm32<ABL>(k0, qr[ks], pa0);
                pa1 = mm32<ABL>(k1, qr[ks], pa1);
            }
            if (needB) {
#pragma unroll
                for (int ks = 0; ks < 4; ++ks) {
                    const bf16x8 k2 = (ABL == 2) ? qr[ks] : *(const bf16x8*)(Kb + kch[ks] + 64 * 128);
                    const bf16x8 k3 = (ABL == 2) ? qr[ks] : *(const bf16x8*)(Kb + kch[ks] + 96 * 128);
                    pb0 = mm32<ABL>(k2, qr[ks], pb0);
                    pb1 = mm32<ABL>(k3, qr[ks], pb1);
                }
            }
            if constexpr (BAND) {
                const int kb = 128 * bandi;
#pragma unroll
                for (int r = 0; r < 16; ++r) {
                    const int kv = kb + crow(r, hi);
                    if (kv > qrel) pa0[r] = -INFINITY;
                    if (kv + 32 > qrel) pa1[r] = -INFINITY;
                    if (kv + 64 > qrel) pb0[r] = -INFINITY;
                    if (kv + 96 > qrel) pb1[r] = -INFINITY;
                }
            }
            if constexpr (ABL != 3) {
            float ra = MX3(pa0[0], pa1[0], pb0[0]), rb2 = MX3(pb1[0], pa0[1], pa1[1]);
            ra = MX3(ra, pb0[1], pb1[1]);
#pragma unroll
            for (int r = 2; r < 16; r += 2) { ra = MX3(ra, pa0[r], pa1[r]); rb2 = MX3(rb2, pb0[r], pb1[r]); ra = MX3(ra, pa0[r + 1], pa1[r + 1]); rb2 = MX3(rb2, pb0[r + 1], pb1[r + 1]); }
            float rm = fmaxf(ra, rb2);
            rm = fmaxf(rm, __shfl_xor(rm, 32)) + cq;
            if (__any(rm > m_run + 6.f)) {
                const float m_new = fmaxf(m_run, rm);
                const float alpha = ex2_(m_run - m_new);
                m_run = m_new;
                l_run *= alpha;
#pragma unroll
                for (int r = 0; r < 16; ++r) { o0[r] *= alpha; o1[r] *= alpha; }
            }
            const float e = cq - m_run;
            float ps0 = 0.f, ps1 = 0.f;
#pragma unroll
            for (int r = 0; r < 16; ++r) {
                pa0[r] = ex2_(pa0[r] + e); pa1[r] = ex2_(pa1[r] + e); pb0[r] = ex2_(pb0[r] + e); pb1[r] = ex2_(pb1[r] + e);
                ps0 += pa0[r] + pa1[r]; ps1 += pb0[r] + pb1[r];
            }
            l_run += ps0 + ps1;
            }
            bf16x8 pf[8];
#define PKF(P, B) __builtin_bit_cast(bf16x8, (u32x4){pk2(P[B], P[B + 1]), pk2(P[B + 2], P[B + 3]), pk2(P[B + 4], P[B + 5]), pk2(P[B + 6], P[B + 7])})
            pf[0] = PKF(pa0, 0); pf[1] = PKF(pa0, 8); pf[2] = PKF(pa1, 0); pf[3] = PKF(pa1, 8);
            pf[4] = PKF(pb0, 0); pf[5] = PKF(pb0, 8); pf[6] = PKF(pb1, 0); pf[7] = PKF(pb1, 8);
#undef PKF
#pragma unroll
            for (int kk = 0; kk < 8; ++kk) {
                if (kk < 4 || needB) {
                    if constexpr (ABL == 2) { o0 = mm32<ABL>(pf[kk ^ 1], pf[kk], o0); o1 = mm32<ABL>(pf[kk ^ 2], pf[kk], o1); }
                    else {
                    const LAS unsigned char* vp = (const LAS unsigned char*)(Vb + vtr_base + (16 * kk) * 192);
                    const s16x4 l0 = __builtin_bit_cast(s16x4, __builtin_amdgcn_ds_read_tr16_b64_v4i16((LAS s16x4*)(vp)));
                    const s16x4 h0 = __builtin_bit_cast(s16x4, __builtin_amdgcn_ds_read_tr16_b64_v4i16((LAS s16x4*)(vp + 8 * 192)));
                    const s16x4 l1 = __builtin_bit_cast(s16x4, __builtin_amdgcn_ds_read_tr16_b64_v4i16((LAS s16x4*)(vp + 64)));
                    const s16x4 h1 = __builtin_bit_cast(s16x4, __builtin_amdgcn_ds_read_tr16_b64_v4i16((LAS s16x4*)(vp + 64 + 8 * 192)));
                    o0 = mm32<ABL>(((bf16x8){l0[0], l0[1], l0[2], l0[3], h0[0], h0[1], h0[2], h0[3]}), pf[kk], o0);
                    o1 = mm32<ABL>(((bf16x8){l1[0], l1[1], l1[2], l1[3], h1[0], h1[1], h1[2], h1[3]}), pf[kk], o1);
                    }
                }
            }
        }
        if (it + 1 < NI) {
            unsigned char* Kn = Kt + (buf ^ 1) * 16384; unsigned char* Vn = Vt + (buf ^ 1) * 24576;
            *(u32x4*)(Kn + kst) = kreg0; *(u32x4*)(Kn + kst + 64 * 128) = kreg1; *(u32x4*)(Vn + vst) = vreg0; *(u32x4*)(Vn + vst + 64 * 192) = vreg1;
        }
        __syncthreads();
    };
    for (int it = 0; it < NI - 2; ++it) step(it, std::false_type{});
    const bf16_t* zp = c.P + qrow * PW + 3328 + h * 64;
    u32x2 zwv[8];
#pragma unroll
    for (int dh = 0; dh < 2; ++dh)
#pragma unroll
        for (int g4 = 0; g4 < 4; ++g4) zwv[4 * dh + g4] = *(const u32x2*)(zp + 32 * dh + 8 * g4 + 4 * hi);
    for (int it = NI - 2; it < NI; ++it) step(it, std::true_type{});
    const float linv = 1.f / (l_run + __shfl_xor(l_run, 32));
    bf16_t* yp = (ABL ? (c.SB + (size_t)2 * 1024 * 1024 + (size_t)qrel * DM) : (c.Y + qrow * DM)) + 512 + h * 64;
    u32x2 pkq[8];
#pragma unroll
    for (int dh = 0; dh < 2; ++dh)
#pragma unroll
        for (int g4 = 0; g4 < 4; ++g4) {
            const u32x2 zw = zwv[4 * dh + g4];
            float ov[4];
#pragma unroll
            for (int i = 0; i < 4; ++i) ov[i] = (dh == 0 ? o0[4 * g4 + i] : o1[4 * g4 + i]) * linv;
            pkq[4 * dh + g4] = (u32x2){pk2(ov[0] * lo_f(zw[0]), ov[1] * hi_f(zw[0])), pk2(ov[2] * lo_f(zw[1]), ov[3] * hi_f(zw[1]))};
        }
#pragma unroll
    for (int kq = 0; kq < 8; kq += 2) {
        const auto rx = __builtin_amdgcn_permlane32_swap(pkq[kq][0], pkq[kq + 1][0], false, false);
        const auto ry = __builtin_amdgcn_permlane32_swap(pkq[kq][1], pkq[kq + 1][1], false, false);
        *(u32x4*)(yp + 8 * kq + (hi ? 8 : 0)) = (u32x4){rx[0], ry[0], rx[1], ry[1]};
    }
}
#undef MX3

__global__ void __launch_bounds__(NTHREADS, 2) fwd_kernel(Args a) {
    extern __shared__ __attribute__((aligned(16))) unsigned char lds[];
    cg::grid_group grid = cg::this_grid();
    const int G = gridDim.x, bx = blockIdx.x;
    const int vcu = (G % 8 == 0) ? (bx % 8) * (G / 8) + bx / 8 : bx;

    volatile LAS unsigned* st = (volatile LAS unsigned*)((LAS unsigned char*)lds + (LDS_BYTES - 64));
    if (threadIdx.x < 16) st[threadIdx.x] = 0u;
    __syncthreads();
    const XcdBarrier bar = xcd_barrier_post(g_ctl, st);
    if (G == 0x40000000) grid.sync();
#define GRID_BAR() xcd_barrier(bar)

    { const Ctx c = load_ctx(); prologue(c, vcu, G, lds); }
    GRID_BAR();
#ifdef P_SYNC10
    for (int i = 0; i < 10; ++i) GRID_BAR();
#endif
#ifdef P_PRO2
    { const Ctx c = load_ctx(); prologue(c, vcu, G, lds); }
    GRID_BAR();
#endif

    for (int L = 0; L < 2; ++L) {
#ifndef NO_GIN
        {
            const Ctx c = load_ctx();
            pg8::Gemm g{c.XB, c.WinT + (size_t)L * NPAD * 1024, M, NPAD, 1024};
            pg8::StaticOrder S; S.init(M, NPAD, G, bx);
            EpiIn E{c.P, c.LOGF, c.FLOGT, c.SS + L * M, c.LB + L * 256, c.bf + L * 8};
            pg8::gemm_phase<EpiIn, pg8::StaticOrder, true, true>((LAS unsigned char*)lds, g, S, E);
#ifdef P_GIN2
            __syncthreads();
            pg8::gemm_phase<EpiIn, pg8::StaticOrder, true, true>((LAS unsigned char*)lds, g, S, E);
#endif
        }
#endif
        GRID_BAR();
#ifndef NO_HU
        { const Ctx c = load_ctx(); for (int it = vcu; it < 512; it += 2 * G) hgrn_u_pair(c, it, it + G < 512 ? it + G : -1, lds, c.ctl + CW_HU + 64 * L); }
#endif
#ifndef NO_GM
        { const Ctx c = load_ctx(); for (int it = vcu; it < 512; it += 2 * G) gmlp_pair(c, L, it, it + G < 512 ? it + G : -1, lds); }
#endif
#ifndef NO_FOX
        { const Ctx c = load_ctx();
          for (int pi = vcu; pi < 256; pi += G) {
            const int bh = pi >> 3, s = pi & 7;
            for (int u = 0; u < 2; ++u) fox_unit<0>(c, bh, (u & 1) ? s : 15 - s, lds);
#ifdef P_ABL
            for (int u = 0; u < 2; ++u) fox_unit<P_ABL>(c, bh, (u & 1) ? s : 15 - s, lds);
#endif
          } }
#endif
        { const Ctx c = load_ctx(); for (int it = vcu; it < 32; it += G) hgrn_scan_item(c, it, c.ctl + CW_HU + 64 * L); }
        GRID_BAR();
#ifndef NO_HO
        { const Ctx c = load_ctx(); for (int it = vcu; it < 512; it += G) hgrn_o_item(c, L, it, lds); }
#ifdef P_HO2
        { const Ctx c = load_ctx(); for (int it = vcu; it < 512; it += G) hgrn_o_item(c, L, it, lds); }
#endif
#endif
        GRID_BAR();
#ifndef NO_GOUT
        {
            const Ctx c = load_ctx();
            pg8::Gemm g{c.Y, c.WoutT + (size_t)L * 1024 * 1024, M, 1024, 1024};
            pg8::StaticOrder S; S.init(M, 1024, G, bx);
#ifdef P_GOUT2
            { EpiOut E2{L == 0 ? c.x : c.out, (float*)c.P, c.P + (size_t)32 * 1024 * 1024, c.LOGF};
              pg8::gemm_phase<EpiOut, pg8::StaticOrder, false, true>((LAS unsigned char*)lds, g, S, E2); __syncthreads(); }
#endif
            if (L == 1 && G == 256) {
                EpiOutFinal E{c.out, c.out, c.SS + 2 * M, c.ctl + CW_PANEL, c.gfin};
                pg8::gemm_phase<EpiOutFinal, pg8::StaticOrder, true, true>((LAS unsigned char*)lds, g, S, E);
            } else {
                EpiOut E{L == 0 ? c.x : c.out, c.out, c.XB, c.SS + (L + 1) * M};
                pg8::gemm_phase<EpiOut, pg8::StaticOrder, true, true>((LAS unsigned char*)lds, g, S, E);
            }
        }
#endif
        if (!(L == 1 && G == 256)) GRID_BAR();
    }
    if (G != 256) {
        const Ctx c = load_ctx();
        const int tid = opaque_tid(), lane = tid & 63, wave = tid >> 6;
        for (int r = vcu * 8 + wave; r < M; r += G * 8) {
            const float rs = rsqrtf(c.SS[2 * M + r] * (1.f / DM) + EPS);
            f32x4* xr = (f32x4*)(c.out + (size_t)r * DM) + lane;
#pragma unroll
            for (int j = 0; j < 4; ++j) { f32x4 v = xr[64 * j]; const f32x4 gg = ((const f32x4*)c.gfin)[lane + 64 * j]; v = v * rs * gg; xr[64 * j] = v; }
        }
    }
    {
        const int tid = opaque_tid();
        asm volatile("s_waitcnt vmcnt(0)" ::: "memory");
        __syncthreads();
        if (tid == 0) st[4] = (xb_add(&g_ctl[CW_DONE], 1u) == (unsigned)(G - 1)) ? 1u : 0u;
        __syncthreads();
        if (st[4]) { for (int i = tid; i < CTL_WORDS; i += NTHREADS) __hip_atomic_store(&g_ctl[i], 0u, __ATOMIC_RELAXED, __HIP_MEMORY_SCOPE_AGENT); }
    }
}

extern "C" void kernel_launch(void* const* d_in, const int* in_sizes, int n_in, void* d_out, int out_size, void* d_ws, size_t ws_size, hipStream_t stream) {
    static int grid = 0;
    if (grid == 0) {
        int dev = 0, cus = 0, per_cu = 0;
        hipGetDevice(&dev);
        hipDeviceGetAttribute(&cus, hipDeviceAttributeMultiprocessorCount, dev);
        hipFuncSetAttribute((const void*)fwd_kernel, hipFuncAttributeMaxDynamicSharedMemorySize, LDS_BYTES);
        hipOccupancyMaxActiveBlocksPerMultiprocessor(&per_cu, (const void*)fwd_kernel, NTHREADS, LDS_BYTES);
        if (per_cu < 1) fprintf(stderr, "kernel_launch: occupancy query says %d blocks per CU\n", per_cu);
        grid = cus;
        (void)hipGetLastError();
    }
    Args a{};
    for (int i = 0; i < 12; ++i) a.in[i] = (const float*)d_in[i];
    a.out = (float*)d_out; a.ws = (unsigned char*)d_ws;
    void* args[] = {&a};
    hipError_t e = hipLaunchCooperativeKernel((const void*)fwd_kernel, dim3(grid), dim3(NTHREADS), args, LDS_BYTES, stream);
    if (e != hipSuccess) fprintf(stderr, "cooperative launch failed: %s (grid %d)\n", hipGetErrorString(e), grid);
}
```

```cpp
#include <hip/hip_runtime.h>
#include <hip/hip_cooperative_groups.h>
#include <cstdio>
#include <cstdint>
#include <type_traits>
namespace cg = cooperative_groups;
namespace pg8 {
#define PG8_LAS __attribute__((address_space(3)))
typedef unsigned short bf16_t;
typedef short bf16x8 __attribute__((ext_vector_type(8)));
typedef float f32x4 __attribute__((ext_vector_type(4)));
typedef unsigned u32x4 __attribute__((ext_vector_type(4)));
constexpr int BM = 256, BK = 64, HALF = 128, HTB = HALF * BK * 2  , STAGE_BYTES = 8 * HTB, NXCD = 8, WGM = 8;

__host__ __device__ __forceinline__ int lds_byte(int r, int c) { const int st = (r >> 4) * 2 + (c >> 5), rr = r & 15, cc = c & 31, ob = rr * 64 + cc * 2; return st * 1024 + (ob ^ (((ob >> 9) & 1) << 5)); }
__host__ __device__ __forceinline__ void stage_rc(int b, int& R, int& C) { const int st = b / 1024, sb = b % 1024, swz = sb ^ (((sb >> 9) & 1) << 5); R = (st >> 1) * 16 + swz / 64; C = (st & 1) * 32 + (swz % 64) / 2; }
__host__ __device__ __forceinline__ int perm32(int rho) { const int n = rho >> 4, i = rho & 15; return 8 * (i >> 2) + 4 * n + (i & 3); }

struct Unit { int pm, pn; };
struct Gemm { const bf16_t* A; const bf16_t* Bt; int M, N, K; };

struct StaticOrder {
    int nM, nN, nwg, G, c;
    __host__ __device__ void init(int M, int N, int G_, int c_) { nM = M / BM; nN = N / BM; nwg = nM * nN; G = G_; c = c_; }
    __host__ __device__ bool next(int i, Unit& u) const {
        const long L = (long)i * G + c; if (L >= nwg) return false;
        int wgid = (int)L; { const int q = nwg / NXCD, r = nwg % NXCD, xcd = wgid % NXCD, off = wgid / NXCD; wgid = (xcd < r ? xcd * (q + 1) : r * (q + 1) + (xcd - r) * q) + off; }
        const int nig = WGM * nN, gid = wgid / nig, fm = gid * WGM, gsz = (nM - fm) < WGM ? (nM - fm) : WGM;
        u.pm = fm + ((wgid % nig) % gsz); u.pn = (wgid % nig) / gsz; return true;
    }
    __device__ __forceinline__ void a_ready(const Unit&) const {}
    __device__ __forceinline__ void done(const Unit&) const {}
};

__device__ __forceinline__ unsigned cvt_pk_bf16(float lo, float hi) { unsigned r; asm volatile("v_cvt_pk_bf16_f32 %0, %1, %2" : "=v"(r) : "v"(lo), "v"(hi)); return r; }
template <class Epi, class Sched, bool ALIGN_EPI = false, bool SP2 = false>
__device__ __forceinline__ void gemm_phase(PG8_LAS unsigned char* lds, const Gemm g, const Sched& S, const Epi& E) {
    int tid_ = threadIdx.x; asm volatile("" : "+v"(tid_)); const int tid = tid_, wid = __builtin_amdgcn_readfirstlane(tid >> 6), lane = tid & 63, wr = wid >> 2, wc = wid & 3, fr = lane & 15, fq = lane >> 4;
    const int K = g.K, nt = K / BK;
    unsigned voffA[2], voffB[2];
#pragma unroll
    for (int i = 0; i < 2; ++i) { int R, C; stage_rc(tid * 16 + i * 8192, R, C); const int Rb = Epi::PERM ? ((R & ~31) + perm32(R & 31)) : R;
        voffA[i] = (unsigned)(R * K + C) * 2u; voffB[i] = (unsigned)(Rb * K + C) * 2u; }
    const size_t kstep = (size_t)(BK * 2);
    const size_t hstep = (size_t)HALF * K * 2;
    const size_t tstep = 2 * hstep;
    const unsigned ldsw = (unsigned)wid * 1024u;
    const int aoff = lds_byte(wr * 64 + fr, fq * 8), boff = lds_byte(wc * 32 + fr, fq * 8);
#define PG8_SA(b, h) (((b) * 2 + (h)) * HTB)
#define PG8_SB(b, h) ((4 + (b) * 2 + (h)) * HTB)
#define PG8_STAGE(bufoff, gbase, voff) do { _Pragma("unroll") for (int _i = 0; _i < 2; ++_i) \
        __builtin_amdgcn_global_load_lds((const unsigned*)((const char*)(gbase) + (voff)[_i]), (PG8_LAS unsigned*)(lds + (bufoff) + ldsw + _i * 8192), 16, 0, 0); } while (0)
#define PG8_LDA(dst, b, h) do { _Pragma("unroll") for (int m = 0; m < 4; ++m) _Pragma("unroll") for (int k = 0; k < 2; ++k) dst[m][k] = *(const PG8_LAS bf16x8*)(lds + PG8_SA(b, h) + aoff + m * 2048 + k * 1024); } while (0)
#define PG8_LDB(dst, b, h) do { _Pragma("unroll") for (int n = 0; n < 2; ++n) _Pragma("unroll") for (int k = 0; k < 2; ++k) dst[n][k] = *(const PG8_LAS bf16x8*)(lds + PG8_SB(b, h) + boff + n * 2048 + k * 1024); } while (0)
#define PG8_MMA(ai, bj, At, Bt) do { __builtin_amdgcn_s_setprio(1); _Pragma("unroll") for (int m = 0; m < 4; ++m) _Pragma("unroll") for (int n = 0; n < 2; ++n) _Pragma("unroll") for (int k = 0; k < 2; ++k) \
        acc[ai][bj][m][n] = __builtin_amdgcn_mfma_f32_16x16x32_bf16(Bt[n][k], At[m][k], acc[ai][bj][m][n], 0, 0, 0); __builtin_amdgcn_s_setprio(0); } while (0)
#define PG8_WAIT_V(n) asm volatile("s_waitcnt vmcnt(" #n ")" ::: "memory")
#define PG8_WAIT_L(n) asm volatile("s_waitcnt lgkmcnt(" #n ")" ::: "memory")
#define PG8_BAR __builtin_amdgcn_s_barrier()
#define PG8_SCHED __builtin_amdgcn_sched_barrier(0)
    Unit cur, nxt; int ui = 0;
    if (!S.next(0, cur)) return;
    f32x4 acc[2][2][4][2];
#pragma unroll
    for (int a = 0; a < 2; ++a)
#pragma unroll
        for (int b = 0; b < 2; ++b)
#pragma unroll
            for (int m = 0; m < 4; ++m)
#pragma unroll
                for (int n = 0; n < 2; ++n) acc[a][b][m][n] = (f32x4){0.f, 0.f, 0.f, 0.f};
    bf16x8 At[4][2], B0[2][2], B1[2][2];
    const char* cA = (const char*)g.A + (size_t)cur.pm * tstep; const char* cB = (const char*)g.Bt + (size_t)cur.pn * tstep;
    S.a_ready(cur);
    if constexpr (SP2) {
        PG8_STAGE(PG8_SB(0, 0), cB, voffB); PG8_STAGE(PG8_SB(0, 1), cB + hstep, voffB); PG8_STAGE(PG8_SA(0, 0), cA, voffA); PG8_STAGE(PG8_SA(0, 1), cA + hstep, voffA);
        if (wr == 1) PG8_BAR;
        PG8_WAIT_V(2); PG8_BAR;
        PG8_STAGE(PG8_SB(1, 0), cB + kstep, voffB); PG8_STAGE(PG8_SA(1, 0), cA + kstep, voffA); PG8_STAGE(PG8_SB(1, 1), cB + hstep + kstep, voffB);
        PG8_WAIT_V(6); PG8_BAR;
    } else {
        PG8_STAGE(PG8_SB(0, 0), cB, voffB); PG8_STAGE(PG8_SA(0, 0), cA, voffA); PG8_STAGE(PG8_SB(0, 1), cB + hstep, voffB); PG8_STAGE(PG8_SA(0, 1), cA + hstep, voffA);
        if (wr == 1) PG8_BAR;
        PG8_WAIT_V(4); PG8_BAR;
        PG8_STAGE(PG8_SB(1, 0), cB + kstep, voffB); PG8_STAGE(PG8_SA(1, 0), cA + kstep, voffA); PG8_STAGE(PG8_SB(1, 1), cB + hstep + kstep, voffB);
        PG8_WAIT_V(6); PG8_BAR;
    }
    for (;;) {
        const bool has_next = S.next(ui + 1, nxt);
        const char* nA = has_next ? (const char*)g.A + (size_t)nxt.pm * tstep : cA; const char* nB = has_next ? (const char*)g.Bt + (size_t)nxt.pn * tstep : cB;
        for (int t = 0; t < nt; t += 2) {
            const bool last = (t == nt - 2);
            const char* a1 = cA + (size_t)(t + 1) * kstep;
            const char* a2 = last ? nA : cA + (size_t)(t + 2) * kstep; const char* b2 = last ? nB : cB + (size_t)(t + 2) * kstep;
            const char* a3 = a2 + kstep; const char* b3 = b2 + kstep;
            if (last && has_next) S.a_ready(nxt);
            if constexpr (SP2) {
            PG8_LDB(B0, 0, 0); PG8_LDB(B1, 0, 1); PG8_SCHED; PG8_LDA(At, 0, 0); PG8_STAGE(PG8_SA(1, 1), a1 + hstep, voffA);
            PG8_WAIT_V(8); PG8_WAIT_L(0); PG8_BAR; PG8_MMA(0, 0, At, B0); PG8_MMA(0, 1, At, B1); PG8_BAR; PG8_SCHED;
            PG8_LDA(At, 0, 1); PG8_STAGE(PG8_SB(0, 0), b2, voffB); PG8_STAGE(PG8_SB(0, 1), b2 + hstep, voffB); PG8_STAGE(PG8_SA(0, 0), a2, voffA);
            PG8_WAIT_V(8); PG8_WAIT_L(0); PG8_BAR; PG8_MMA(1, 0, At, B0); PG8_MMA(1, 1, At, B1); PG8_BAR; PG8_SCHED;
            PG8_LDB(B0, 1, 0); PG8_LDB(B1, 1, 1); PG8_SCHED; PG8_LDA(At, 1, 0); PG8_STAGE(PG8_SA(0, 1), a2 + hstep, voffA);
            PG8_WAIT_V(8); PG8_WAIT_L(0); PG8_BAR; PG8_MMA(0, 0, At, B0); PG8_MMA(0, 1, At, B1); PG8_BAR; PG8_SCHED;
            PG8_LDA(At, 1, 1); PG8_STAGE(PG8_SB(1, 0), b3, voffB); PG8_STAGE(PG8_SB(1, 1), b3 + hstep, voffB); PG8_STAGE(PG8_SA(1, 0), a3, voffA);
            PG8_WAIT_V(8); PG8_WAIT_L(0); PG8_BAR; PG8_MMA(1, 0, At, B0); PG8_MMA(1, 1, At, B1); PG8_BAR; PG8_SCHED;
            } else {
            PG8_LDB(B0, 0, 0); PG8_SCHED; PG8_LDA(At, 0, 0); PG8_STAGE(PG8_SA(1, 1), a1 + hstep, voffA);
            PG8_WAIT_L(8); PG8_BAR; PG8_WAIT_L(0); PG8_MMA(0, 0, At, B0); PG8_BAR; PG8_SCHED;
            PG8_LDB(B1, 0, 1); PG8_STAGE(PG8_SB(0, 0), b2, voffB);
            PG8_BAR; PG8_WAIT_L(0); PG8_MMA(0, 1, At, B1); PG8_BAR;
            PG8_LDA(At, 0, 1); PG8_STAGE(PG8_SA(0, 0), a2, voffA);
            PG8_BAR; PG8_WAIT_L(0); PG8_MMA(1, 0, At, B0); PG8_BAR; PG8_SCHED;
            PG8_STAGE(PG8_SB(0, 1), b2 + hstep, voffB);
            PG8_WAIT_V(6); PG8_BAR; PG8_MMA(1, 1, At, B1); PG8_BAR;
            PG8_LDB(B0, 1, 0); PG8_SCHED; PG8_LDA(At, 1, 0); PG8_STAGE(PG8_SA(0, 1), a2 + hstep, voffA);
            PG8_WAIT_L(8); PG8_BAR; PG8_WAIT_L(0); PG8_MMA(0, 0, At, B0); PG8_BAR; PG8_SCHED;
            PG8_LDB(B1, 1, 1); PG8_STAGE(PG8_SB(1, 0), b3, voffB);
            PG8_BAR; PG8_WAIT_L(0); PG8_MMA(0, 1, At, B1); PG8_BAR;
            PG8_LDA(At, 1, 1); PG8_STAGE(PG8_SA(1, 0), a3, voffA);
            PG8_BAR; PG8_WAIT_L(0); PG8_MMA(1, 0, At, B0); PG8_BAR; PG8_SCHED;
            PG8_STAGE(PG8_SB(1, 1), b3 + hstep, voffB);
            PG8_WAIT_V(6); PG8_BAR; PG8_MMA(1, 1, At, B1); PG8_BAR;
            }
        }
        if constexpr (ALIGN_EPI) { if (wr == 0) PG8_BAR; }
        if constexpr (!Epi::AFTER_DRAIN) { E(acc, cur, wr, wc, fr, fq); S.done(cur); }
        if (!has_next) break;
#pragma unroll
        for (int a = 0; a < 2; ++a)
#pragma unroll
            for (int b = 0; b < 2; ++b)
#pragma unroll
                for (int m = 0; m < 4; ++m)
#pragma unroll
                    for (int n = 0; n < 2; ++n) acc[a][b][m][n] = (f32x4){0.f, 0.f, 0.f, 0.f};
        cur = nxt; cA = nA; cB = nB; ++ui;
        if constexpr (ALIGN_EPI) { if (wr == 1) PG8_BAR; }
    }
    PG8_WAIT_V(0);
    if constexpr (!ALIGN_EPI) { if (wr == 0) PG8_BAR; }
    PG8_BAR;
    if constexpr (Epi::AFTER_DRAIN) { E.fused(acc, cur, wr, wc, fr, fq, lds, wid, lane); S.done(cur); }
#undef PG8_SA
#undef PG8_SB
#undef PG8_STAGE
#undef PG8_LDA
#undef PG8_LDB
#undef PG8_MMA
#undef PG8_WAIT_V
#undef PG8_WAIT_L
#undef PG8_BAR
#undef PG8_SCHED
}
}

#define DI __device__ __forceinline__
typedef unsigned short bf16_t;
typedef short bf16x8 __attribute__((ext_vector_type(8)));
typedef short s16x4 __attribute__((ext_vector_type(4)));
typedef float f32x4 __attribute__((ext_vector_type(4)));
typedef float f32x16 __attribute__((ext_vector_type(16)));
typedef unsigned u32x4 __attribute__((ext_vector_type(4)));
typedef unsigned u32x2 __attribute__((ext_vector_type(2)));
#define LAS __attribute__((address_space(3)))

#define XB_TMO      128
#define XB_XCNT(j)  (256  + 64 * (j))
#define XB_XSUB(j)  (1280 + 64 * (j))
#define XB_XGEN(j)  (2304 + 64 * (j))
#define XB_TOP      3328
#define XB_TOPGEN   3392
#define XCD_BAR_WORDS 3456
#define XB_SPIN_CAP (1u << 18)

__device__ __forceinline__ unsigned xb_ld(unsigned* p)              { return __hip_atomic_load(p, __ATOMIC_RELAXED, __HIP_MEMORY_SCOPE_AGENT); }
__device__ __forceinline__ unsigned xb_add(unsigned* p, unsigned v) { return __hip_atomic_fetch_add(p, v, __ATOMIC_RELAXED, __HIP_MEMORY_SCOPE_AGENT); }
__device__ __forceinline__ unsigned xb_xcc_id() { return (unsigned)__builtin_amdgcn_s_getreg((3 << 11) | 20) & 0xFu; }
#define XB_SPIN(cond, bar) do { unsigned _sp = 0; while (cond) { __builtin_amdgcn_s_sleep(1); \
    if ((++_sp & 255u) == 0u) { if (xb_ld(&(bar)[XB_TMO])) break; if (_sp > XB_SPIN_CAP) { atomicAdd(&(bar)[XB_TMO], 1u); break; } } } } while (0)

struct XcdBarrier {
    unsigned* bar; unsigned x;
    volatile LAS unsigned* st;
};

__device__ __forceinline__ XcdBarrier xcd_barrier_post(unsigned* bar, volatile LAS unsigned* st) {
    XcdBarrier b; b.bar = bar; b.x = xb_xcc_id(); b.st = st;
    if (threadIdx.x == 0) (void)xb_add(&bar[XB_XCNT(b.x)], 1u);
    return b;
}
__device__ __forceinline__ void xcd_barrier_complete(unsigned* bar, unsigned x, unsigned& nloc, unsigned& nx) {
    const unsigned G = gridDim.x * gridDim.y * gridDim.z;
    unsigned sum, cnt, mine, sp = 0u;
    for (;;) {
        sum = 0u; cnt = 0u; mine = 0u;
#pragma unroll
        for (unsigned j = 0; j < 16; ++j) { const unsigned c = xb_ld(&bar[XB_XCNT(j)]); sum += c; cnt += (c > 0u) ? 1u : 0u; mine = (j == x) ? c : mine; }
        if (sum == G) break;
        __builtin_amdgcn_s_sleep(1);
        if ((++sp & 255u) == 0u) { if (xb_ld(&bar[XB_TMO])) break; if (sp > XB_SPIN_CAP) { atomicAdd(&bar[XB_TMO], 1u); break; } }
    }
    nloc = mine > 0u ? mine : 1u; nx = cnt > 0u ? cnt : 1u;
}

__device__ __forceinline__ void xcd_barrier(const XcdBarrier& b) {
    asm volatile("s_waitcnt vmcnt(0)" ::: "memory");
    __syncthreads();
    if (threadIdx.x == 0) {
        unsigned* bar = b.bar;
        __builtin_amdgcn_s_waitcnt(0);
        unsigned nloc = b.st[0], nx = b.st[1];
        if (nloc == 0u) { xcd_barrier_complete(bar, b.x, nloc, nx); b.st[0] = nloc; b.st[1] = nx; }
        const unsigned old = xb_add(&bar[XB_XSUB(b.x)], 1u);
        const unsigned gen = old / nloc;
        if (old + 1u == (gen + 1u) * nloc) {
            __builtin_amdgcn_fence(__ATOMIC_RELEASE, "agent");
            asm volatile("s_waitcnt vmcnt(0)" ::: "memory");
            const unsigned og = xb_add(&bar[XB_TOP], 1u);
            const unsigned tg = og / nx;
            if (og + 1u == (tg + 1u) * nx) xb_add(&bar[XB_TOPGEN], 1u);
            else XB_SPIN(xb_ld(&bar[XB_TOPGEN]) == tg, bar);
            __builtin_amdgcn_fence(__ATOMIC_ACQUIRE, "agent");
            xb_add(&bar[XB_XGEN(b.x)], 1u);
            asm volatile("s_waitcnt vmcnt(0)" ::: "memory");
        } else {
            XB_SPIN(xb_ld(&bar[XB_XGEN(b.x)]) == gen, bar);
            __builtin_amdgcn_fence(__ATOMIC_ACQUIRE, "agent");
            asm volatile("s_waitcnt vmcnt(0)" ::: "memory");
        }
    }
    __syncthreads();
}


constexpr int NTHREADS = 512;
constexpr int LDS_BYTES = 147456;
constexpr int M = 16384, DM = 1024, SEQ = 4096, NB = 4;
constexpr int DIN = 3848, NPAD = 4096, PW = 3840;
constexpr float EPS = 1e-6f;
constexpr float LOG2E = 1.4426950408889634f;
constexpr float C2 = 0.125f * LOG2E;

constexpr size_t MiB = 1u << 20;
constexpr size_t WS_WIN = 0;
constexpr size_t WS_WOUT = 16 * MiB;
constexpr size_t WS_SS = 20 * MiB;
constexpr size_t WS_LB = 20 * MiB + 512 * 1024;
constexpr size_t WS_FLOGT = 21 * MiB;
constexpr size_t WS_DD = 22 * MiB;
constexpr size_t WS_CTL = 23 * MiB, CTL_BYTES = 65536;
constexpr size_t WS_U = 24 * MiB;
constexpr size_t WS_XB = 32 * MiB;
constexpr size_t WS_Y = 64 * MiB;
constexpr size_t WS_LOGF = 96 * MiB;
constexpr size_t WS_P = 112 * MiB;
constexpr size_t WS_SB = 232 * MiB;
constexpr int CW_PANEL = 8192;
constexpr int CW_HU = 3584;

struct Args { const float* in[12]; float* out; unsigned char* ws; };

constexpr int CTL_WORDS = 16384, CW_DONE = 16000;
__device__ unsigned g_ctl[CTL_WORDS];

struct Ctx {
    const float *x, *norm_g, *w_in, *w_out, *ln_g, *ln_b, *w_s, *b_s, *hlb, *og, *bf, *gfin;
    float* out;
    bf16_t *WinT, *WoutT, *XB, *Y, *P;
    float *SS, *LB, *FLOGT, *DD, *U, *LOGF;
    bf16_t* SB; unsigned* ctl;
};

DI const void* karg_ptr(int byte_off) {
    const __attribute__((address_space(1))) void* p;
    asm volatile("s_load_dwordx2 %0, %1, %2\n\ts_waitcnt lgkmcnt(0)" : "=s"(p) : "s"(__builtin_amdgcn_kernarg_segment_ptr()), "i"(byte_off) : "memory");
    return (const void*)p;
}
#define KARG(i) karg_ptr((i) * 8)
DI Ctx load_ctx() {
    Ctx c;
    c.x = (const float*)KARG(0); c.norm_g = (const float*)KARG(1); c.w_in = (const float*)KARG(2); c.w_out = (const float*)KARG(3);
    c.ln_g = (const float*)KARG(4); c.ln_b = (const float*)KARG(5); c.w_s = (const float*)KARG(6); c.b_s = (const float*)KARG(7);
    c.hlb = (const float*)KARG(8); c.og = (const float*)KARG(9); c.bf = (const float*)KARG(10); c.gfin = (const float*)KARG(11);
    c.out = (float*)KARG(12);
    unsigned char* ws = (unsigned char*)KARG(13);
    c.WinT = (bf16_t*)(ws + WS_WIN); c.WoutT = (bf16_t*)(ws + WS_WOUT); c.XB = (bf16_t*)(ws + WS_XB); c.Y = (bf16_t*)(ws + WS_Y); c.P = (bf16_t*)(ws + WS_P);
    c.SS = (float*)(ws + WS_SS); c.LB = (float*)(ws + WS_LB); c.FLOGT = (float*)(ws + WS_FLOGT); c.DD = (float*)(ws + WS_DD); c.U = (float*)(ws + WS_U); c.LOGF = (float*)(ws + WS_LOGF);
    c.SB = (bf16_t*)(ws + WS_SB); c.ctl = g_ctl;
    return c;
}

DI int opaque_tid() { int t = threadIdx.x; asm volatile("" : "+v"(t)); return t; }
DI float bf2f(bf16_t b) { return __uint_as_float(((unsigned)b) << 16); }
typedef float f32x2_t __attribute__((ext_vector_type(2)));
typedef __bf16 bf16x2_t __attribute__((ext_vector_type(2)));
DI unsigned pk2(float lo, float hi) { const f32x2_t v = {lo, hi}; const bf16x2_t b = __builtin_convertvector(v, bf16x2_t); return __builtin_bit_cast(unsigned, b); }
DI unsigned f2bf(float f) { return pk2(f, 0.f) & 0xffffu; }
DI float lo_f(unsigned w) { return __uint_as_float(w << 16); }
DI float hi_f(unsigned w) { return __uint_as_float(w & 0xffff0000u); }
DI float wave_sum(float v) {
#pragma unroll
    for (int o = 1; o < 64; o <<= 1) v += __shfl_xor(v, o);
    return v;
}
DI float rcp_(float x) { return __builtin_amdgcn_rcpf(x); }
DI float ex2_(float x) { return __builtin_amdgcn_exp2f(x); }
DI float sigmoidf_(float z) { return rcp_(1.f + ex2_(-LOG2E * z)); }
DI float siluf_(float z) { return z * rcp_(1.f + ex2_(-LOG2E * z)); }
DI float geluf_(float x) { const float u = 0.7978845608028654f * (x + 0.044715f * x * x * x); return x * rcp_(1.f + ex2_(-2.f * LOG2E * u)); }
#define MFMA16(a, b, c) __builtin_amdgcn_mfma_f32_16x16x32_bf16((a), (b), (c), 0, 0, 0)
#define MFMA32(a, b, c) __builtin_amdgcn_mfma_f32_32x32x16_bf16((a), (b), (c), 0, 0, 0)

struct EpiIn {
    static constexpr bool PERM = true, AFTER_DRAIN = false;
    bf16_t* P; float* LOGF; float* FLOGT; const float* ss; const float* lb; const float* bfl;
    DI void operator()(const f32x4 (&acc)[2][2][4][2], const pg8::Unit& u, int wr, int wc, int fr, int fq) const {
        const int pn = u.pn;
        const int rowb = u.pm * 256 + wr * 64 + fr;
        float rsv[2][4];
#pragma unroll
        for (int ai = 0; ai < 2; ++ai)
#pragma unroll
            for (int m = 0; m < 4; ++m) rsv[ai][m] = ss[rowb + ai * 128 + m * 16];
#pragma unroll
        for (int ai = 0; ai < 2; ++ai)
#pragma unroll
            for (int m = 0; m < 4; ++m) rsv[ai][m] = rsqrtf(rsv[ai][m] * (1.f / DM) + EPS);
        if (pn == 15) {
            if (wc == 0 && fq == 0) {
#pragma unroll
                for (int ai = 0; ai < 2; ++ai)
#pragma unroll
                    for (int m = 0; m < 4; ++m) {
                        const int row = rowb + ai * 128 + m * 16;
                        const float rs = rsv[ai][m];
                        const int b = row >> 12, s = row & 4095;
#pragma unroll
                        for (int n = 0; n < 2; ++n)
#pragma unroll
                            for (int i = 0; i < 4; ++i) {
                                const int h = 4 * n + i;
                                const float t = acc[ai][0][m][n][i] * rs + bfl[h];
                                const float ls = fminf(t, 0.f) - log1pf(expf(-fabsf(t)));
                                FLOGT[(size_t)(b * 8 + h) * SEQ + s] = ls * LOG2E;
                            }
                    }
            }
            return;
        }
        int mode = 0; float scale = 1.f;
        if (pn <= 1) mode = 1;
        else if (pn == 2 || pn == 6 || pn >= 13) mode = 2;
        else if (pn == 3) { mode = 2; scale = 0.125f; }
        else if (pn == 4) mode = 3;
        else if (pn == 7 || pn == 8) scale = C2;
        const int cl = wc * 32 + 8 * fq;
#pragma unroll
        for (int ai = 0; ai < 2; ++ai)
#pragma unroll
            for (int m = 0; m < 4; ++m) {
                const int row = rowb + ai * 128 + m * 16;
                const float rs = rsv[ai][m];
#pragma unroll
                for (int bj = 0; bj < 2; ++bj) {
                    const int ct = bj * 128 + cl;
                    float v[8];
#pragma unroll
                    for (int i = 0; i < 4; ++i) { v[i] = acc[ai][bj][m][0][i] * rs; v[4 + i] = acc[ai][bj][m][1][i] * rs; }
                    if (mode == 1) {
#pragma unroll
                        for (int i = 0; i < 8; ++i) v[i] = geluf_(v[i]);
                    } else if (mode == 2) {
#pragma unroll
                        for (int i = 0; i < 8; ++i) v[i] = siluf_(v[i]) * scale;
                    } else if (mode == 3) {
                        float lf[8];
#pragma unroll
                        for (int i = 0; i < 8; ++i) {
                            const float l = lb[ct + i], z = v[i];
                            const float sg = sigmoidf_(z);
                            const float f = l + (1.f - l) * sg;
                            lf[i] = __logf(fmaxf(f, 1e-30f));
                            v[i] = (1.f - l) * sigmoidf_(-z);
                        }
                        float* lp = LOGF + (size_t)row * 256 + ct;
                        *(f32x4*)lp = (f32x4){lf[0], lf[1], lf[2], lf[3]};
                        *(f32x4*)(lp + 4) = (f32x4){lf[4], lf[5], lf[6], lf[7]};
                    } else {
#pragma unroll
                        for (int i = 0; i < 8; ++i) v[i] *= scale;
                    }
                    u32x4 w; w.x = pk2(v[0], v[1]); w.y = pk2(v[2], v[3]); w.z = pk2(v[4], v[5]); w.w = pk2(v[6], v[7]);
                    *(u32x4*)(P + (size_t)row * PW + pn * 256 + ct) = w;
                }
            }
    }
};

struct EpiOut {
    static constexpr bool PERM = true, AFTER_DRAIN = false;
    const float* xin; float* xout; bf16_t* XB; float* ssn;
    DI void operator()(const f32x4 (&acc)[2][2][4][2], const pg8::Unit& u, int wr, int wc, int fr, int fq) const {
        const int rowb = u.pm * 256 + wr * 64 + fr;
        const int cb = u.pn * 256 + wc * 32 + 8 * fq;
#pragma unroll
        for (int ai = 0; ai < 2; ++ai) {
            f32x4 xv[4][2][2];
#pragma unroll
            for (int m = 0; m < 4; ++m)
#pragma unroll
                for (int bj = 0; bj < 2; ++bj) {
                    const size_t o = (size_t)(rowb + ai * 128 + m * 16) * DM + cb + bj * 128;
                    xv[m][bj][0] = *(const f32x4*)(xin + o); xv[m][bj][1] = *(const f32x4*)(xin + o + 4);
                }
#pragma unroll
            for (int m = 0; m < 4; ++m) {
                const int row = rowb + ai * 128 + m * 16;
                float sq = 0.f;
#pragma unroll
                for (int bj = 0; bj < 2; ++bj) {
                    const size_t o = (size_t)row * DM + cb + bj * 128;
                    f32x4 x0 = xv[m][bj][0], x1 = xv[m][bj][1];
                    x0 = x0 + acc[ai][bj][m][0]; x1 = x1 + acc[ai][bj][m][1];
                    *(f32x4*)(xout + o) = x0; *(f32x4*)(xout + o + 4) = x1;
                    u32x4 w; w.x = pk2(x0[0], x0[1]); w.y = pk2(x0[2], x0[3]); w.z = pk2(x1[0], x1[1]); w.w = pk2(x1[2], x1[3]);
                    *(u32x4*)(XB + o) = w;
                    sq += x0[0] * x0[0] + x0[1] * x0[1] + x0[2] * x0[2] + x0[3] * x0[3] + x1[0] * x1[0] + x1[1] * x1[1] + x1[2] * x1[2] + x1[3] * x1[3];
                }
                sq += __shfl_xor(sq, 16); sq += __shfl_xor(sq, 32);
                if (fq == 0) atomicAdd(ssn + row, sq);
            }
        }
    }
};

struct EpiOutFinal {
    static constexpr bool PERM = true, AFTER_DRAIN = false;
    const float* xin; float* out; float* ss; unsigned* pcnt; const float* gf;
    DI void operator()(const f32x4 (&acc_)[2][2][4][2], const pg8::Unit& u, int wr, int wc, int fr, int fq) const {
        f32x4 (&acc)[2][2][4][2] = const_cast<f32x4 (&)[2][2][4][2]>(acc_);
        const int rowb = u.pm * 256 + wr * 64 + fr;
        const int cb = u.pn * 256 + wc * 32 + 8 * fq;
#pragma unroll
        for (int ai = 0; ai < 2; ++ai)
#pragma unroll
            for (int m = 0; m < 4; ++m) {
                const int row = rowb + ai * 128 + m * 16;
                float sq = 0.f;
#pragma unroll
                for (int bj = 0; bj < 2; ++bj) {
                    const size_t o = (size_t)row * DM + cb + bj * 128;
                    const f32x4 x0 = *(const f32x4*)(xin + o) + acc[ai][bj][m][0], x1 = *(const f32x4*)(xin + o + 4) + acc[ai][bj][m][1];
                    acc[ai][bj][m][0] = x0; acc[ai][bj][m][1] = x1;
                    sq += x0[0] * x0[0] + x0[1] * x0[1] + x0[2] * x0[2] + x0[3] * x0[3] + x1[0] * x1[0] + x1[1] * x1[1] + x1[2] * x1[2] + x1[3] * x1[3];
                }
                sq += __shfl_xor(sq, 16); sq += __shfl_xor(sq, 32);
                if (fq == 0) atomicAdd(ss + row, sq);
            }
        asm volatile("s_waitcnt vmcnt(0)" ::: "memory");
        __syncthreads();
        if (threadIdx.x == 0) {
            __builtin_amdgcn_fence(__ATOMIC_RELEASE, "agent"); asm volatile("s_waitcnt vmcnt(0)" ::: "memory");
            unsigned* pc = pcnt + 64 * u.pm;
            xb_add(pc, 1u);
            unsigned sp = 0;
            while (xb_ld(pc) < 4u) { __builtin_amdgcn_s_sleep(1); if (++sp > (1u << 22)) break; }
            __builtin_amdgcn_fence(__ATOMIC_ACQUIRE, "agent"); asm volatile("s_waitcnt vmcnt(0)" ::: "memory");
        }
        __syncthreads();
#pragma unroll
        for (int ai = 0; ai < 2; ++ai)
#pragma unroll
            for (int m = 0; m < 4; ++m) {
                const int row = rowb + ai * 128 + m * 16;
                const float rs = rsqrtf(__hip_atomic_load(ss + row, __ATOMIC_RELAXED, __HIP_MEMORY_SCOPE_AGENT) * (1.f / DM) + EPS);
#pragma unroll
                for (int bj = 0; bj < 2; ++bj) {
                    const int col = cb + bj * 128;
                    const f32x4 g0 = *(const f32x4*)(gf + col), g1 = *(const f32x4*)(gf + col + 4);
                    const size_t o = (size_t)row * DM + col;
                    *(f32x4*)(out + o) = acc[ai][bj][m][0] * rs * g0; *(f32x4*)(out + o + 4) = acc[ai][bj][m][1] * rs * g1;
                }
            }
    }
};

DI void transpose_item(const float* W, int N, bf16_t* WT, const float* g, int kb, int nb, float* scr, int lane) {
    const int k0 = 64 * kb, n0 = 64 * nb;
    const bool nok = (n0 + lane) < N;
    float v[64];
#pragma unroll
    for (int i = 0; i < 64; ++i) v[i] = nok ? __builtin_nontemporal_load(W + (size_t)(k0 + i) * N + n0 + lane) : 0.f;
    if (g) {
#pragma unroll
        for (int i = 0; i < 64; ++i) v[i] *= g[k0 + i];
    }
#pragma unroll
    for (int i = 0; i < 64; ++i) scr[i * 65 + lane] = v[i];
    asm volatile("s_waitcnt lgkmcnt(0)" ::: "memory");
    const int cch = lane & 7;
#pragma unroll
    for (int j = 0; j < 8; ++j) {
        const int n = (lane >> 3) + 8 * j;
        const float* sp = scr + (8 * cch) * 65 + n;
        u32x4 o; o.x = pk2(sp[0], sp[65]); o.y = pk2(sp[2 * 65], sp[3 * 65]); o.z = pk2(sp[4 * 65], sp[5 * 65]); o.w = pk2(sp[6 * 65], sp[7 * 65]);
        if (n0 + n < N) *(u32x4*)(WT + (size_t)(n0 + n) * 1024 + k0 + 8 * cch) = o;
    }
    asm volatile("s_waitcnt lgkmcnt(0)" ::: "memory");
}

DI void prologue(const Ctx& c, int vcu, int G, unsigned char* lds) {
    const int tid = opaque_tid(), lane = tid & 63, wave = tid >> 6;
    const int gw = vcu * 8 + wave, NGW = G * 8;
    float* scr = (float*)lds + wave * (64 * 65);
#pragma unroll 8
    for (int r = vcu * 8 + wave; r < M; r += G * 8) {
        const f32x4* xr = (const f32x4*)(c.x + (size_t)r * DM) + lane;
        u32x2* o8 = (u32x2*)(c.XB + (size_t)r * DM) + lane;
        float s = 0.f;
#pragma unroll
        for (int j = 0; j < 4; ++j) { const f32x4 v = __builtin_nontemporal_load(xr + 64 * j); s += v[0] * v[0] + v[1] * v[1] + v[2] * v[2] + v[3] * v[3];
            o8[64 * j] = (u32x2){pk2(v[0], v[1]), pk2(v[2], v[3])}; }
        s = wave_sum(s);
        if (lane == 0) c.SS[r] = s;
    }
    constexpr int NB_IN = (DIN + 63) / 64, IT_IN = 16 * NB_IN, IT_OUT = 16 * 16;
    for (int it = gw; it < 2 * IT_IN + 2 * IT_OUT; it += NGW) {
        int r = it;
        if (r < 2 * IT_IN) { const int L = r / IT_IN; r -= L * IT_IN;
            transpose_item(c.w_in + (size_t)L * 1024 * DIN, DIN, c.WinT + (size_t)L * NPAD * 1024, c.norm_g + L * 1024, r / NB_IN, r % NB_IN, scr, lane); }
        else { r -= 2 * IT_IN; const int L = r / IT_OUT; r -= L * IT_OUT;
            transpose_item(c.w_out + (size_t)L * 1024 * 1024, 1024, c.WoutT + (size_t)L * 1024 * 1024, nullptr, r / 16, r % 16, scr, lane); }
    }
    for (int i = vcu * NTHREADS + tid; i < 2 * 248 * 128; i += G * NTHREADS) {
        const int L = i / (248 * 128), r = i % (248 * 128);
        *(u32x4*)(c.WinT + (size_t)L * NPAD * 1024 + (size_t)(DIN + r / 128) * 1024 + (r % 128) * 8) = (u32x4){0u, 0u, 0u, 0u};
    }
    for (int i = vcu * NTHREADS + tid; i < 2 * M; i += G * NTHREADS) c.SS[M + i] = 0.f;
    for (int i = vcu * NTHREADS + tid; i < 256; i += G * NTHREADS) {
        const float l0 = c.hlb[i], l1 = c.hlb[256 + i], mx = fmaxf(l0, l1);
        const float e0 = expf(l0 - mx), e1 = expf(l1 - mx);
        const float p0 = e0 / (e0 + e1), p1 = e1 / (e0 + e1);
        c.LB[i] = fminf(fmaxf(p0 - p0, 0.f), 1.f - 1e-6f);
        c.LB[256 + i] = fminf(fmaxf((p0 + p1) - p0, 0.f), 1.f - 1e-6f);
    }
}

DI void hgrn_cumsum(const float* LOGF, size_t row0, int h, float* segtot, float (&bl)[16], float& tot) {
    const int tid = opaque_tid(), k = tid & 63, seg = tid >> 6;
    const float* lf = LOGF + (row0 + seg * 16) * 256 + h * 64 + k;
    float run = 0.f;
#pragma unroll
    for (int i = 0; i < 16; ++i) { run += lf[(size_t)i * 256]; bl[i] = run; }
    segtot[seg * 64 + k] = run;
    __syncthreads();
    float off = 0.f; tot = 0.f;
#pragma unroll
    for (int s2 = 0; s2 < 8; ++s2) { const float v = segtot[s2 * 64 + k]; if (s2 < seg) off += v; tot += v; }
#pragma unroll
    for (int i = 0; i < 16; ++i) bl[i] += off;
}
DI void stage_colT(const bf16_t* P, size_t row0, int colbase, bf16_t* img) {
    const int tid = opaque_tid(), k = tid & 63, seg = tid >> 6;
    const bf16_t* p = P + (row0 + seg * 16) * PW + colbase + k;
    unsigned w[8];
#pragma unroll
    for (int i = 0; i < 8; ++i) w[i] = (unsigned)p[(size_t)(2 * i) * PW] | ((unsigned)p[(size_t)(2 * i + 1) * PW] << 16);
    u32x4* d = (u32x4*)(img + k * 136 + seg * 16);
    d[0] = (u32x4){w[0], w[1], w[2], w[3]}; d[1] = (u32x4){w[4], w[5], w[6], w[7]};
}

DI void hgrn_u_pair(const Ctx& c, int itA, int itB, unsigned char* lds, unsigned* cnt) {
    const int tid = opaque_tid(), lane = tid & 63, wave = tid >> 6, fr = lane & 15, fq = lane >> 4;
    const int k = tid & 63, seg = tid >> 6;
    const int items[2] = {itA, itB >= 0 ? itB : itA};
    constexpr int ISZ = 64 * 136 * 2 * 2 + 2048;
    float bl[2][16]; unsigned short kr[2][16];
    size_t row0[2]; int hh[2];
#pragma unroll
    for (int u = 0; u < 2; ++u) {
        const int item = items[u], b = item >> 7, h = (item >> 5) & 3, ch = item & 31;
        hh[u] = h; row0[u] = (size_t)b * SEQ + ch * 128;
        const float* lf = c.LOGF + (row0[u] + seg * 16) * 256 + h * 64 + k;
        const bf16_t* kp = c.P + (row0[u] + seg * 16) * PW + 1024 + h * 64 + k;
#pragma unroll
        for (int i = 0; i < 16; ++i) { bl[u][i] = lf[(size_t)i * 256]; kr[u][i] = kp[(size_t)i * PW]; }
    }
#pragma unroll
    for (int u = 0; u < 2; ++u) stage_colT(c.P, row0[u], 1280 + hh[u] * 64, (bf16_t*)(lds + u * ISZ) + 64 * 136);
#pragma unroll
    for (int u = 0; u < 2; ++u) {
        float* segtot = (float*)(lds + u * ISZ + 64 * 136 * 4);
        float run = 0.f;
#pragma unroll
        for (int i = 0; i < 16; ++i) { run += bl[u][i]; bl[u][i] = run; }
        segtot[seg * 64 + k] = run;
    }
    __syncthreads();
#pragma unroll
    for (int u = 0; u < 2; ++u) {
        const float* segtot = (const float*)(lds + u * ISZ + 64 * 136 * 4);
        bf16_t* kdT = (bf16_t*)(lds + u * ISZ);
        float off = 0.f, tot = 0.f;
#pragma unroll
        for (int s2 = 0; s2 < 8; ++s2) { const float v = segtot[s2 * 64 + k]; if (s2 < seg) off += v; tot += v; }
        const float tb = tot - off;
        unsigned w[8];
#pragma unroll
        for (int i = 0; i < 8; ++i)
            w[i] = pk2(bf2f(kr[u][2 * i]) * __expf(tb - bl[u][2 * i]), bf2f(kr[u][2 * i + 1]) * __expf(tb - bl[u][2 * i + 1]));
        u32x4* d = (u32x4*)(kdT + k * 136 + seg * 16);
        d[0] = (u32x4){w[0], w[1], w[2], w[3]}; d[1] = (u32x4){w[4], w[5], w[6], w[7]};
        if (seg == 0) c.DD[(size_t)items[u] * 64 + k] = __expf(tot);
    }
    __syncthreads();
    const int mt = wave >> 1, nt0 = (wave & 1) * 2;
#pragma unroll
    for (int u = 0; u < 2; ++u) {
        const bf16_t* kdT = (const bf16_t*)(lds + u * ISZ);
        const bf16_t* vT = kdT + 64 * 136;
        f32x4 acc[2] = {(f32x4){0.f, 0.f, 0.f, 0.f}, (f32x4){0.f, 0.f, 0.f, 0.f}};
#pragma unroll
        for (int ks = 0; ks < 4; ++ks) {
            const bf16x8 A = *(const bf16x8*)(kdT + (mt * 16 + fr) * 136 + ks * 32 + fq * 8);
#pragma unroll
            for (int n2 = 0; n2 < 2; ++n2) {
                const bf16x8 B = *(const bf16x8*)(vT + ((nt0 + n2) * 16 + fr) * 136 + ks * 32 + fq * 8);
                acc[n2] = MFMA16(A, B, acc[n2]);
            }
        }
        float* Up = c.U + (size_t)items[u] * 4096;
#pragma unroll
        for (int n2 = 0; n2 < 2; ++n2) *(f32x4*)(Up + ((nt0 + n2) * 16 + fr) * 64 + mt * 16 + fq * 4) = acc[n2];
    }
    asm volatile("s_waitcnt vmcnt(0)" ::: "memory");
    __syncthreads();
    if (tid == 0) { __builtin_amdgcn_fence(__ATOMIC_RELEASE, "agent"); asm volatile("s_waitcnt vmcnt(0)" ::: "memory"); xb_add(cnt, itB >= 0 ? 2u : 1u); }
}

DI void gmlp_pair(const Ctx& c, int L, int itA, int itB, unsigned char* lds) {
    const int tid = opaque_tid(), lane = tid & 63, wave = tid >> 6, fr = lane & 15, fq = lane >> 4;
    const int items[2] = {itA, itB >= 0 ? itB : itA};
    constexpr int VS = 136;
    size_t row0[2]; int gg[2];
    u32x4 w0[2], w1[2];
#pragma unroll
    for (int u = 0; u < 2; ++u) {
        const int item = items[u], b = item >> 7, n = (item >> 2) & 31, g = item & 3;
        gg[u] = g; row0[u] = (size_t)b * SEQ + n * 128;
        const bf16_t* src = c.P + (row0[u] + (tid >> 2)) * PW + 256 + g * 64 + (tid & 3) * 16;
        w0[u] = *(const u32x4*)src; w1[u] = *(const u32x4*)(src + 8);
    }
    unsigned short gur[2][4][4], szr[2][4][4];
#pragma unroll
    for (int u = 0; u < 2; ++u)
#pragma unroll
        for (int nt = 0; nt < 4; ++nt)
#pragma unroll
            for (int reg = 0; reg < 4; ++reg) {
                const size_t row = row0[u] + wave * 16 + fq * 4 + reg; const int cc = gg[u] * 64 + nt * 16 + fr;
                gur[u][nt][reg] = c.P[row * PW + cc]; szr[u][nt][reg] = c.P[row * PW + 512 + cc];
            }
#pragma unroll
    for (int u = 0; u < 2; ++u) {
        bf16_t* vnT = (bf16_t*)lds + u * 64 * VS;
        const int s = tid >> 2, part = tid & 3, g = gg[u];
        float x[16];
#pragma unroll
        for (int i = 0; i < 4; ++i) { x[2 * i] = lo_f(w0[u][i]); x[2 * i + 1] = hi_f(w0[u][i]); x[8 + 2 * i] = lo_f(w1[u][i]); x[8 + 2 * i + 1] = hi_f(w1[u][i]); }
        float sum = 0.f;
#pragma unroll
        for (int i = 0; i < 16; ++i) sum += x[i];
        sum += __shfl_xor(sum, 1); sum += __shfl_xor(sum, 2);
        const float mean = sum * (1.f / 64.f);
        float sq = 0.f;
#pragma unroll
        for (int i = 0; i < 16; ++i) { x[i] -= mean; sq += x[i] * x[i]; }
        sq += __shfl_xor(sq, 1); sq += __shfl_xor(sq, 2);
        const float rstd = rsqrtf(sq * (1.f / 64.f) + EPS);
        const float* lg = c.ln_g + L * 256 + g * 64 + part * 16;
        const float* lbp = c.ln_b + L * 256 + g * 64 + part * 16;
#pragma unroll
        for (int i = 0; i < 16; ++i) vnT[(part * 16 + i) * VS + s] = (bf16_t)f2bf(x[i] * rstd * lg[i] + lbp[i]);
    }
    __syncthreads();
    const int t = wave * 16 + fr;
    const int ksmax = (wave * 16 + 15) >> 5;
#pragma unroll
    for (int u = 0; u < 2; ++u) {
        const bf16_t* vnT = (const bf16_t*)lds + u * 64 * VS;
        const int g = gg[u];
        f32x4 acc[4];
#pragma unroll
        for (int i = 0; i < 4; ++i) acc[i] = (f32x4){0.f, 0.f, 0.f, 0.f};
        const float* wrow = c.w_s + ((size_t)(L * 4 + g) * 128 + t) * 128;
        for (int ks = 0; ks <= ksmax; ++ks) {
            const int s0 = ks * 32 + fq * 8;
            const f32x4 wa = *(const f32x4*)(wrow + s0), wb = *(const f32x4*)(wrow + s0 + 4);
            float wv[8] = {wa[0], wa[1], wa[2], wa[3], wb[0], wb[1], wb[2], wb[3]};
#pragma unroll
            for (int j = 0; j < 8; ++j) if (s0 + j > t) wv[j] = 0.f;
            u32x4 aw; aw.x = pk2(wv[0], wv[1]); aw.y = pk2(wv[2], wv[3]); aw.z = pk2(wv[4], wv[5]); aw.w = pk2(wv[6], wv[7]);
            const bf16x8 A = __builtin_bit_cast(bf16x8, aw);
#pragma unroll
            for (int nt = 0; nt < 4; ++nt) {
                const bf16x8 B = *(const bf16x8*)(vnT + (nt * 16 + fr) * VS + s0);
                acc[nt] = MFMA16(A, B, acc[nt]);
            }
        }
        const float* bsp = c.b_s + (size_t)(L * 4 + g) * 128 + wave * 16 + fq * 4;
#pragma unroll
        for (int nt = 0; nt < 4; ++nt) {
            const int cc = g * 64 + nt * 16 + fr;
#pragma unroll
            for (int reg = 0; reg < 4; ++reg) {
                const size_t row = row0[u] + wave * 16 + fq * 4 + reg;
                const float mixed = acc[nt][reg] + bsp[reg];
                c.Y[row * DM + cc] = (bf16_t)f2bf(bf2f(gur[u][nt][reg]) * mixed * bf2f(szr[u][nt][reg]));
            }
        }
    }
    __syncthreads();
}

DI void hgrn_scan_item(const Ctx& c, int item, unsigned* cnt) {
    const int tid = opaque_tid();
    if (tid == 0) {
        unsigned sp = 0;
        while (xb_ld(cnt) < 512u) { __builtin_amdgcn_s_sleep(1); if (++sp > (1u << 22)) break; }
        __builtin_amdgcn_fence(__ATOMIC_ACQUIRE, "agent");
        asm volatile("s_waitcnt vmcnt(0)" ::: "memory");
    }
    __syncthreads();
    const int bhh = item >> 1, vh = item & 1;
    const int v = vh * 32 + (tid >> 4), k4 = (tid & 15) * 4;
    const float* Ub = c.U + (size_t)bhh * 32 * 4096 + v * 64 + k4;
    const float* Db = c.DD + (size_t)bhh * 32 * 64 + k4;
    bf16_t* Sb = c.SB + (size_t)bhh * 32 * 4096 + v * 64 + k4;
    f32x4 S = (f32x4){0.f, 0.f, 0.f, 0.f};
    for (int j0 = 0; j0 < 32; j0 += 8) {
        f32x4 u[8], d[8];
#pragma unroll
        for (int j = 0; j < 8; ++j) { u[j] = *(const f32x4*)(Ub + (size_t)(j0 + j) * 4096); d[j] = *(const f32x4*)(Db + (size_t)(j0 + j) * 64); }
#pragma unroll
        for (int j = 0; j < 8; ++j) {
            *(u32x2*)(Sb + (size_t)(j0 + j) * 4096) = (u32x2){pk2(S[0], S[1]), pk2(S[2], S[3])};
            S = d[j] * S + u[j];
        }
    }
}

DI void hgrn_o_item(const Ctx& c, int L, int item, unsigned char* lds) {
    const int tid = opaque_tid(), lane = tid & 63, wave = tid >> 6, fr = lane & 15, fq = lane >> 4;
    const int b = item >> 7, h = (item >> 5) & 3, ch = item & 31;
    const size_t row0 = (size_t)b * SEQ + ch * 128;
    bf16_t* qs = (bf16_t*)lds;
    bf16_t* ks_ = qs + 128 * 72;
    float* bs = (float*)(ks_ + 128 * 72);
    bf16_t* vT = (bf16_t*)(bs + 128 * 68);
    bf16_t* ST = vT + 64 * 136;
    bf16_t* Ab = ST + 64 * 72;
    float* segtot = (float*)(Ab + 8 * 16 * 136);
    const int k = tid & 63, seg = tid >> 6;
    const u32x4 sbv = *(const u32x4*)(c.SB + (size_t)item * 4096 + (tid >> 3) * 64 + (tid & 7) * 8);
    float bl[16]; unsigned short vr[16];
    {
        const float* lf = c.LOGF + (row0 + seg * 16) * 256 + h * 64 + k;
        const bf16_t* vp = c.P + (row0 + seg * 16) * PW + 1280 + h * 64 + k;
#pragma unroll
        for (int i = 0; i < 16; ++i) { bl[i] = lf[(size_t)i * 256]; vr[i] = vp[(size_t)i * PW]; }
    }
    u32x4 qv[2], kv[2];
#pragma unroll
    for (int i = 0; i < 2; ++i) {
        const int id = tid + 512 * i, t = id >> 3, cc = id & 7;
        qv[i] = *(const u32x4*)(c.P + (row0 + t) * PW + 768 + h * 64 + cc * 8);
        kv[i] = *(const u32x4*)(c.P + (row0 + t) * PW + 1024 + h * 64 + cc * 8);
    }
    unsigned short zg[4][4];
#pragma unroll
    for (int nt = 0; nt < 4; ++nt)
#pragma unroll
        for (int reg = 0; reg < 4; ++reg) zg[nt][reg] = c.P[(row0 + wave * 16 + 4 * fq + reg) * PW + 1536 + h * 64 + nt * 16 + fr];
    *(u32x4*)(ST + (tid >> 3) * 72 + (tid & 7) * 8) = sbv;
#pragma unroll
    for (int i = 0; i < 2; ++i) {
        const int id = tid + 512 * i, t = id >> 3, cc = id & 7;
        *(u32x4*)(qs + t * 72 + cc * 8) = qv[i];
        *(u32x4*)(ks_ + t * 72 + cc * 8) = kv[i];
    }
    {
        u32x4* d = (u32x4*)(vT + k * 136 + seg * 16);
        d[0] = (u32x4){(unsigned)vr[0] | ((unsigned)vr[1] << 16), (unsigned)vr[2] | ((unsigned)vr[3] << 16), (unsigned)vr[4] | ((unsigned)vr[5] << 16), (unsigned)vr[6] | ((unsigned)vr[7] << 16)};
        d[1] = (u32x4){(unsigned)vr[8] | ((unsigned)vr[9] << 16), (unsigned)vr[10] | ((unsigned)vr[11] << 16), (unsigned)vr[12] | ((unsigned)vr[13] << 16), (unsigned)vr[14] | ((unsigned)vr[15] << 16)};
    }
    {
        float run = 0.f;
#pragma unroll
        for (int i = 0; i < 16; ++i) { run += bl[i]; bl[i] = run; }
        segtot[seg * 64 + k] = run;
    }
    __syncthreads();
    {
        float off = 0.f;
#pragma unroll
        for (int s2 = 0; s2 < 8; ++s2) { const float v = segtot[s2 * 64 + k]; if (s2 < seg) off += v; }
#pragma unroll
        for (int i = 0; i < 16; ++i) bs[(seg * 16 + i) * 68 + k] = bl[i] + off;
    }
    __syncthreads();
    const int w = wave;
    const float* brow = bs + (w * 16 + fr) * 68;
    const float* rho = bs + (w * 16) * 68;
    bf16x8 Aq[2], Aqs[2];
#pragma unroll
    for (int k2 = 0; k2 < 2; ++k2) {
        const int k0 = k2 * 32 + fq * 8;
        const u32x4 qw = *(const u32x4*)(qs + (w * 16 + fr) * 72 + k0);
        const f32x4 b0 = *(const f32x4*)(brow + k0), b1 = *(const f32x4*)(brow + k0 + 4);
        const f32x4 r0 = *(const f32x4*)(rho + k0), r1 = *(const f32x4*)(rho + k0 + 4);
        float q[8] = {lo_f(qw[0]), hi_f(qw[0]), lo_f(qw[1]), hi_f(qw[1]), lo_f(qw[2]), hi_f(qw[2]), lo_f(qw[3]), hi_f(qw[3])};
        float bb[8] = {b0[0], b0[1], b0[2], b0[3], b1[0], b1[1], b1[2], b1[3]};
        float rr[8] = {r0[0], r0[1], r0[2], r0[3], r1[0], r1[1], r1[2], r1[3]};
        u32x4 a, as;
#pragma unroll
        for (int j = 0; j < 4; ++j) {
            a[j] = pk2(q[2 * j] * __expf(bb[2 * j] - rr[2 * j]), q[2 * j + 1] * __expf(bb[2 * j + 1] - rr[2 * j + 1]));
            as[j] = pk2(q[2 * j] * __expf(bb[2 * j]), q[2 * j + 1] * __expf(bb[2 * j + 1]));
        }
        Aq[k2] = __builtin_bit_cast(bf16x8, a); Aqs[k2] = __builtin_bit_cast(bf16x8, as);
    }
    bf16_t* Aw = Ab + w * 16 * 136;
    for (int J = 0; J <= w; ++J) {
        f32x4 sc = (f32x4){0.f, 0.f, 0.f, 0.f};
#pragma unroll
        for (int k2 = 0; k2 < 2; ++k2) {
            const int k0 = k2 * 32 + fq * 8;
            const u32x4 kw = *(const u32x4*)(ks_ + (J * 16 + fr) * 72 + k0);
            const float* bk = bs + (J * 16 + fr) * 68 + k0;
            const f32x4 b0 = *(const f32x4*)bk, b1 = *(const f32x4*)(bk + 4);
            const f32x4 r0 = *(const f32x4*)(rho + k0), r1 = *(const f32x4*)(rho + k0 + 4);
            float kk[8] = {lo_f(kw[0]), hi_f(kw[0]), lo_f(kw[1]), hi_f(kw[1]), lo_f(kw[2]), hi_f(kw[2]), lo_f(kw[3]), hi_f(kw[3])};
            float bb[8] = {b0[0], b0[1], b0[2], b0[3], b1[0], b1[1], b1[2], b1[3]};
            float rr[8] = {r0[0], r0[1], r0[2], r0[3], r1[0], r1[1], r1[2], r1[3]};
            u32x4 bw;
#pragma unroll
            for (int j = 0; j < 4; ++j)
                bw[j] = pk2(kk[2 * j] * __expf(fminf(rr[2 * j] - bb[2 * j], 80.f)), kk[2 * j + 1] * __expf(fminf(rr[2 * j + 1] - bb[2 * j + 1], 80.f)));
            sc = MFMA16(Aq[k2], __builtin_bit_cast(bf16x8, bw), sc);
        }
#pragma unroll
        for (int reg = 0; reg < 4; ++reg) {
            const int tl = 4 * fq + reg;
            float val = sc[reg];
            if (J == w && fr > tl) val = 0.f;
            Aw[tl * 136 + J * 16 + fr] = (bf16_t)f2bf(val);
        }
    }
    if ((w & 1) == 0) {
#pragma unroll
        for (int reg = 0; reg < 4; ++reg) Aw[(4 * fq + reg) * 136 + (w + 1) * 16 + fr] = (bf16_t)0;
    }
    asm volatile("s_waitcnt lgkmcnt(0)" ::: "memory");
    f32x4 o[4];
#pragma unroll
    for (int i = 0; i < 4; ++i) o[i] = (f32x4){0.f, 0.f, 0.f, 0.f};
    const int nks = (16 * (w + 1) + 31) >> 5;
    for (int k2 = 0; k2 < nks; ++k2) {
        const bf16x8 A = *(const bf16x8*)(Aw + fr * 136 + k2 * 32 + fq * 8);
#pragma unroll
        for (int nt = 0; nt < 4; ++nt) {
            const bf16x8 B = *(const bf16x8*)(vT + (nt * 16 + fr) * 136 + k2 * 32 + fq * 8);
            o[nt] = MFMA16(A, B, o[nt]);
        }
    }
#pragma unroll
    for (int k2 = 0; k2 < 2; ++k2)
#pragma unroll
        for (int nt = 0; nt < 4; ++nt) {
            const bf16x8 B = *(const bf16x8*)(ST + (nt * 16 + fr) * 72 + k2 * 32 + fq * 8);
            o[nt] = MFMA16(Aqs[k2], B, o[nt]);
        }
    const float* ogp = c.og + L * 64;
#pragma unroll
    for (int reg = 0; reg < 4; ++reg) {
        float ssq = 0.f;
#pragma unroll
        for (int nt = 0; nt < 4; ++nt) ssq += o[nt][reg] * o[nt][reg];
        ssq += __shfl_xor(ssq, 1); ssq += __shfl_xor(ssq, 2); ssq += __shfl_xor(ssq, 4); ssq += __shfl_xor(ssq, 8);
        const float rinv = rsqrtf(ssq * (1.f / 64.f) + EPS);
        const size_t row = row0 + w * 16 + 4 * fq + reg;
#pragma unroll
        for (int nt = 0; nt < 4; ++nt) {
            const int v = nt * 16 + fr;
            const float y = o[nt][reg] * rinv * ogp[v] * bf2f(zg[nt][reg]);
            c.Y[row * DM + 256 + h * 64 + v] = (bf16_t)f2bf(y);
        }
    }
    __syncthreads();
}

DI int crow(int r, int hi) { return (r & 3) + 8 * (r >> 2) + 4 * hi; }
#define MX3(a, b, c) __builtin_fmaxf(__builtin_fmaxf((a), (b)), (c))
template <int ABL> DI f32x16 mm32(bf16x8 a, bf16x8 b, f32x16 c) {
    if constexpr (ABL == 1) { asm volatile("" :: "v"(a), "v"(b)); return c; } else return MFMA32(a, b, c);
}
template <int ABL> DI void fox_unit(const Ctx& c, int bh, int qb, unsigned char* lds) {
    const int tid = opaque_tid(), lane = tid & 63, wave = tid >> 6, r32 = lane & 31, hi = lane >> 5;
    const int b = bh >> 3, h = bh & 7;
    const size_t rowb = (size_t)b * SEQ;
    float* cL = (float*)lds;
    unsigned char* Kt = lds + 16384;
    unsigned char* Vt = lds + 16384 + 32768;
    float* wtot = (float*)(lds + 16384 + 32768 + 49152);
    const int nkeys = 256 * (qb + 1), NI = 2 * (qb + 1);
    f32x4 fl0 = (f32x4){0.f, 0.f, 0.f, 0.f}, fl1 = fl0;
    if (8 * tid < nkeys) { const f32x4* src = (const f32x4*)(c.FLOGT + (size_t)bh * SEQ + 8 * tid); fl0 = src[0]; fl1 = src[1]; }
    const int qrel = wave * 32 + r32;
    const size_t qrow = rowb + 256 * qb + qrel;
    bf16x8 qr[4];
#pragma unroll
    for (int ks = 0; ks < 4; ++ks) qr[ks] = *(const bf16x8*)(c.P + qrow * PW + 1792 + h * 64 + ks * 16 + hi * 8);
    const int skv = tid >> 3, sch = tid & 7;
    const bf16_t* kg = c.P + (rowb + skv) * PW + 2304 + h * 64 + sch * 8;
    const bf16_t* vg = c.P + (rowb + skv) * PW + 2816 + h * 64 + sch * 8;
    const int kst = skv * 128 + ((sch ^ ((skv >> 1) & 7)) * 16), vst = skv * 192 + sch * 16;
    u32x4 kreg0 = *(const u32x4*)kg, kreg1 = *(const u32x4*)(kg + (size_t)64 * PW), vreg0 = *(const u32x4*)vg, vreg1 = *(const u32x4*)(vg + (size_t)64 * PW);
    {
        float v[8]; float run = 0.f;
        if (8 * tid < nkeys) {
            const float t8[8] = {fl0[0], fl0[1], fl0[2], fl0[3], fl1[0], fl1[1], fl1[2], fl1[3]};
#pragma unroll
            for (int i = 0; i < 8; ++i) { run += t8[i]; v[i] = run; }
        } else {
#pragma unroll
            for (int i = 0; i < 8; ++i) v[i] = 0.f;
        }
        float inc = run;
#pragma unroll
        for (int o = 1; o < 64; o <<= 1) { const float t = __shfl_up(inc, o); if (lane >= o) inc += t; }
        if (lane == 63) wtot[wave] = inc;
        __syncthreads();
        float off = inc - run;
        for (int w2 = 0; w2 < wave; ++w2) off += wtot[w2];
        if (8 * tid < nkeys) {
            *(f32x4*)(cL + 8 * tid) = (f32x4){-(v[0] + off), -(v[1] + off), -(v[2] + off), -(v[3] + off)};
            *(f32x4*)(cL + 8 * tid + 4) = (f32x4){-(v[4] + off), -(v[5] + off), -(v[6] + off), -(v[7] + off)};
        }
    }
    *(u32x4*)(Kt + kst) = kreg0; *(u32x4*)(Kt + kst + 64 * 128) = kreg1; *(u32x4*)(Vt + vst) = vreg0; *(u32x4*)(Vt + vst + 64 * 192) = vreg1;
    __syncthreads();
    const float cq = -cL[256 * qb + qrel];
    float m_run = -1e30f, l_run = 0.f;
    f32x16 o0, o1;
#pragma unroll
    for (int i = 0; i < 16; ++i) { o0[i] = 0.f; o1[i] = 0.f; }
    const int vtr_base = (4 * hi + ((lane & 15) >> 2)) * 192 + (((lane >> 4) & 1) * 16 + (lane & 3) * 4) * 2;
    const int kfr_base = r32 * 128;
    int kch[4];
#pragma unroll
    for (int ks = 0; ks < 4; ++ks) kch[ks] = kfr_base + (((2 * ks + hi) ^ ((r32 >> 1) & 7)) * 16);
    asm volatile("" :: "v"(qr[0]), "v"(qr[1]), "v"(qr[2]), "v"(qr[3]));
    auto step = [&](int it, auto band_tag) __attribute__((always_inline)) {
        constexpr bool BAND = decltype(band_tag)::value;
        const int buf = it & 1;
        if (it + 1 < NI) {
            const size_t go = (size_t)(it + 1) * 128 * PW;
            kreg0 = *(const u32x4*)(kg + go); kreg1 = *(const u32x4*)(kg + go + (size_t)64 * PW); vreg0 = *(const u32x4*)(vg + go); vreg1 = *(const u32x4*)(vg + go + (size_t)64 * PW);
        }
        const int bandi = it - (NI - 2);
        const bool needA = !BAND || (128 * bandi <= 32 * wave + 31);
        const bool needB = !BAND || (128 * bandi + 64 <= 32 * wave + 31);
        if (needA) {
            const unsigned char* Kb = Kt + buf * 16384;
            const unsigned char* Vb = Vt + buf * 24576;
            f32x16 pa0, pa1, pb0, pb1;
            {
                const float* ct = cL + 128 * it + 4 * hi;
#pragma unroll
                for (int g4 = 0; g4 < 4; ++g4) {
                    f32x4 c0, c1, c2, c3; if constexpr (ABL == 2) { c0 = c1 = c2 = c3 = (f32x4){cq, cq, cq, cq}; } else { c0 = *(const f32x4*)(ct + 8 * g4); c1 = *(const f32x4*)(ct + 32 + 8 * g4); c2 = *(const f32x4*)(ct + 64 + 8 * g4); c3 = *(const f32x4*)(ct + 96 + 8 * g4); }
#pragma unroll
                    for (int i = 0; i < 4; ++i) { pa0[4 * g4 + i] = c0[i]; pa1[4 * g4 + i] = c1[i]; pb0[4 * g4 + i] = c2[i]; pb1[4 * g4 + i] = c3[i]; }
                }
            }
#pragma unroll
            for (int ks = 0; ks < 4; ++ks) {
                const bf16x8 k0 = (ABL == 2) ? qr[ks] : *(const bf16x8*)(Kb + kch[ks]);
                const bf16x8 k1 = (ABL == 2) ? qr[ks] : *(const bf16x8*)(Kb + kch[ks] + 32 * 128);
                pa0 = mm32<ABL>(k0, qr[ks], pa0);
                pa1 = mm32<ABL>(k1, qr[ks], pa1);
            }
            if (needB) {
#pragma unroll
                for (int ks = 0; ks < 4; ++ks) {
                    const bf16x8 k2 = (ABL == 2) ? qr[ks] : *(const bf16x8*)(Kb + kch[ks] + 64 * 128);
                    const bf16x8 k3 = (ABL == 2) ? qr[ks] : *(const bf16x8*)(Kb + kch[ks] + 96 * 128);
                    pb0 = mm32<ABL>(k2, qr[ks], pb0);
                    pb1 = mm32<ABL>(k3, qr[ks], pb1);
                }
            }
            if constexpr (BAND) {
                const int kb = 128 * bandi;
#pragma unroll
                for (int r = 0; r < 16; ++r) {
                    const int kv = kb + crow(r, hi);
                    if (kv > qrel) pa0[r] = -INFINITY;
                    if (kv + 32 > qrel) pa1[r] = -INFINITY;
                    if (kv + 64 > qrel) pb0[r] = -INFINITY;
                    if (kv + 96 > qrel) pb1[r] = -INFINITY;
                }
            }
            if constexpr (ABL != 3) {
            float ra = MX3(pa0[0], pa1[0], pb0[0]), rb2 = MX3(pb1[0], pa0[1], pa1[1]);
            ra = MX3(ra, pb0[1], pb1[1]);
#pragma unroll
            for (int r = 2; r < 16; r += 2) { ra = MX3(ra, pa0[r], pa1[r]); rb2 = MX3(rb2, pb0[r], pb1[r]); ra = MX3(ra, pa0[r + 1], pa1[r + 1]); rb2 = MX3(rb2, pb0[r + 1], pb1[r + 1]); }
            float rm = fmaxf(ra, rb2);
            rm = fmaxf(rm, __shfl_xor(rm, 32)) + cq;
            if (__any(rm > m_run + 6.f)) {
                const float m_new = fmaxf(m_run, rm);
                const float alpha = ex2_(m_run - m_new);
                m_run = m_new;
                l_run *= alpha;
#pragma unroll
                for (int r = 0; r < 16; ++r) { o0[r] *= alpha; o1[r] *= alpha; }
            }
            const float e = cq - m_run;
            float ps0 = 0.f, ps1 = 0.f;
#pragma unroll
            for (int r = 0; r < 16; ++r) {
                pa0[r] = ex2_(pa0[r] + e); pa1[r] = ex2_(pa1[r] + e); pb0[r] = ex2_(pb0[r] + e); pb1[r] = ex2_(pb1[r] + e);
                ps0 += pa0[r] + pa1[r]; ps1 += pb0[r] + pb1[r];
            }
            l_run += ps0 + ps1;
            }
            bf16x8 pf[8];
#define PKF(P, B) __builtin_bit_cast(bf16x8, (u32x4){pk2(P[B], P[B + 1]), pk2(P[B + 2], P[B + 3]), pk2(P[B + 4], P[B + 5]), pk2(P[B + 6], P[B + 7])})
            pf[0] = PKF(pa0, 0); pf[1] = PKF(pa0, 8); pf[2] = PKF(pa1, 0); pf[3] = PKF(pa1, 8);
            pf[4] = PKF(pb0, 0); pf[5] = PKF(pb0, 8); pf[6] = PKF(pb1, 0); pf[7] = PKF(pb1, 8);
#undef PKF
#pragma unroll
            for (int kk = 0; kk < 8; ++kk) {
                if (kk < 4 || needB) {
                    if constexpr (ABL == 2) { o0 = mm32<ABL>(pf[kk ^ 1], pf[kk], o0); o1 = mm32<ABL>(pf[kk ^ 2], pf[kk], o1); }
                    else {
                    const LAS unsigned char* vp = (const LAS unsigned char*)(Vb + vtr_base + (16 * kk) * 192);
                    const s16x4 l0 = __builtin_bit_cast(s16x4, __builtin_amdgcn_ds_read_tr16_b64_v4i16((LAS s16x4*)(vp)));
                    const s16x4 h0 = __builtin_bit_cast(s16x4, __builtin_amdgcn_ds_read_tr16_b64_v4i16((LAS s16x4*)(vp + 8 * 192)));
                    const s16x4 l1 = __builtin_bit_cast(s16x4, __builtin_amdgcn_ds_read_tr16_b64_v4i16((LAS s16x4*)(vp + 64)));
                    const s16x4 h1 = __builtin_bit_cast(s16x4, __builtin_amdgcn_ds_read_tr16_b64_v4i16((LAS s16x4*)(vp + 64 + 8 * 192)));
                    o0 = mm32<ABL>(((bf16x8){l0[0], l0[1], l0[2], l0[3], h0[0], h0[1], h0[2], h0[3]}), pf[kk], o0);
                    o1 = mm32<ABL>(((bf16x8){l1[0], l1[1], l1[2], l1[3], h1[0], h1[1], h1[2], h1[3]}), pf[kk], o1);
                    }
                }
            }
        }
        if (it + 1 < NI) {
            unsigned char* Kn = Kt + (buf ^ 1) * 16384; unsigned char* Vn = Vt + (buf ^ 1) * 24576;
            *(u32x4*)(Kn + kst) = kreg0; *(u32x4*)(Kn + kst + 64 * 128) = kreg1; *(u32x4*)(Vn + vst) = vreg0; *(u32x4*)(Vn + vst + 64 * 192) = vreg1;
        }
        __syncthreads();
    };
    for (int it = 0; it < NI - 2; ++it) step(it, std::false_type{});
    const bf16_t* zp = c.P + qrow * PW + 3328 + h * 64;
    u32x2 zwv[8];
#pragma unroll
    for (int dh = 0; dh < 2; ++dh)
#pragma unroll
        for (int g4 = 0; g4 < 4; ++g4) zwv[4 * dh + g4] = *(const u32x2*)(zp + 32 * dh + 8 * g4 + 4 * hi);
    for (int it = NI - 2; it < NI; ++it) step(it, std::true_type{});
    const float linv = 1.f / (l_run + __shfl_xor(l_run, 32));
    bf16_t* yp = (ABL ? (c.SB + (size_t)2 * 1024 * 1024 + (size_t)qrel * DM) : (c.Y + qrow * DM)) + 512 + h * 64;
    u32x2 pkq[8];
#pragma unroll
    for (int dh = 0; dh < 2; ++dh)
#pragma unroll
        for (int g4 = 0; g4 < 4; ++g4) {
            const u32x2 zw = zwv[4 * dh + g4];
            float ov[4];
#pragma unroll
            for (int i = 0; i < 4; ++i) ov[i] = (dh == 0 ? o0[4 * g4 + i] : o1[4 * g4 + i]) * linv;
            pkq[4 * dh + g4] = (u32x2){pk2(ov[0] * lo_f(zw[0]), ov[1] * hi_f(zw[0])), pk2(ov[2] * lo_f(zw[1]), ov[3] * hi_f(zw[1]))};
        }
#pragma unroll
    for (int kq = 0; kq < 8; kq += 2) {
        const auto rx = __builtin_amdgcn_permlane32_swap(pkq[kq][0], pkq[kq + 1][0], false, false);
        const auto ry = __builtin_amdgcn_permlane32_swap(pkq[kq][1], pkq[kq + 1][1], false, false);
        *(u32x4*)(yp + 8 * kq + (hi ? 8 : 0)) = (u32x4){rx[0], ry[0], rx[1], ry[1]};
    }
}
#undef MX3

__global__ void __launch_bounds__(NTHREADS, 2) fwd_kernel(Args a) {
    extern __shared__ __attribute__((aligned(16))) unsigned char lds[];
    cg::grid_group grid = cg::this_grid();
    const int G = gridDim.x, bx = blockIdx.x;
    const int vcu = (G % 8 == 0) ? (bx % 8) * (G / 8) + bx / 8 : bx;

    volatile LAS unsigned* st = (volatile LAS unsigned*)((LAS unsigned char*)lds + (LDS_BYTES - 64));
    if (threadIdx.x < 16) st[threadIdx.x] = 0u;
    __syncthreads();
    const XcdBarrier bar = xcd_barrier_post(g_ctl, st);
    if (G == 0x40000000) grid.sync();
#define GRID_BAR() xcd_barrier(bar)

    { const Ctx c = load_ctx(); prologue(c, vcu, G, lds); }
    GRID_BAR();
#ifdef P_SYNC10
    for (int i = 0; i < 10; ++i) GRID_BAR();
#endif
#ifdef P_PRO2
    { const Ctx c = load_ctx(); prologue(c, vcu, G, lds); }
    GRID_BAR();
#endif

    for (int L = 0; L < 2; ++L) {
#ifndef NO_GIN
        {
            const Ctx c = load_ctx();
            pg8::Gemm g{c.XB, c.WinT + (size_t)L * NPAD * 1024, M, NPAD, 1024};
            pg8::StaticOrder S; S.init(M, NPAD, G, bx);
            EpiIn E{c.P, c.LOGF, c.FLOGT, c.SS + L * M, c.LB + L * 256, c.bf + L * 8};
            pg8::gemm_phase<EpiIn, pg8::StaticOrder, true, true>((LAS unsigned char*)lds, g, S, E);
#ifdef P_GIN2
            __syncthreads();
            pg8::gemm_phase<EpiIn, pg8::StaticOrder, true, true>((LAS unsigned char*)lds, g, S, E);
#endif
        }
#endif
        GRID_BAR();
#ifndef NO_HU
        { const Ctx c = load_ctx(); for (int it = vcu; it < 512; it += 2 * G) hgrn_u_pair(c, it, it + G < 512 ? it + G : -1, lds, c.ctl + CW_HU + 64 * L); }
#endif
#ifndef NO_GM
        { const Ctx c = load_ctx(); for (int it = vcu; it < 512; it += 2 * G) gmlp_pair(c, L, it, it + G < 512 ? it + G : -1, lds); }
#endif
#ifndef NO_FOX
        { const Ctx c = load_ctx();
          for (int pi = vcu; pi < 256; pi += G) {
            const int bh = pi >> 3, s = pi & 7;
            for (int u = 0; u < 2; ++u) fox_unit<0>(c, bh, (u & 1) ? s : 15 - s, lds);
#ifdef P_ABL
            for (int u = 0; u < 2; ++u) fox_unit<P_ABL>(c, bh, (u & 1) ? s : 15 - s, lds);
#endif
          } }
#endif
        { const Ctx c = load_ctx(); for (int it = vcu; it < 32; it += G) hgrn_scan_item(c, it, c.ctl + CW_HU + 64 * L); }
        GRID_BAR();
#ifndef NO_HO
        { const Ctx c = load_ctx(); for (int it = vcu; it < 512; it += G) hgrn_o_item(c, L, it, lds); }
#ifdef P_HO2
        { const Ctx c = load_ctx(); for (int it = vcu; it < 512; it += G) hgrn_o_item(c, L, it, lds); }
#endif
#endif
        GRID_BAR();
#ifndef NO_GOUT
        {
            const Ctx c = load_ctx();
            pg8::Gemm g{c.Y, c.WoutT + (size_t)L * 1024 * 1024, M, 1024, 1024};
            pg8::StaticOrder S; S.init(M, 1024, G, bx);
#ifdef P_GOUT2
            { EpiOut E2{L == 0 ? c.x : c.out, (float*)c.P, c.P + (size_t)32 * 1024 * 1024, c.LOGF};
              pg8::gemm_phase<EpiOut, pg8::StaticOrder, false, true>((LAS unsigned char*)lds, g, S, E2); __syncthreads(); }
#endif
            if (L == 1 && G == 256) {
                EpiOutFinal E{c.out, c.out, c.SS + 2 * M, c.ctl + CW_PANEL, c.gfin};
                pg8::gemm_phase<EpiOutFinal, pg8::StaticOrder, true, true>((LAS unsigned char*)lds, g, S, E);
            } else {
                EpiOut E{L == 0 ? c.x : c.out, c.out, c.XB, c.SS + (L + 1) * M};
                pg8::gemm_phase<EpiOut, pg8::StaticOrder, true, true>((LAS unsigned char*)lds, g, S, E);
            }
        }
#endif
        if (!(L == 1 && G == 256)) GRID_BAR();
    }
    if (G != 256) {
        const Ctx c = load_ctx();
        const int tid = opaque_tid(), lane = tid & 63, wave = tid >> 6;
        for (int r = vcu * 8 + wave; r < M; r += G * 8) {
            const float rs = rsqrtf(c.SS[2 * M + r] * (1.f / DM) + EPS);
            f32x4* xr = (f32x4*)(c.out + (size_t)r * DM) + lane;
#pragma unroll
            for (int j = 0; j < 4; ++j) { f32x4 v = xr[64 * j]; const f32x4 gg = ((const f32x4*)c.gfin)[lane + 64 * j]; v = v * rs * gg; xr[64 * j] = v; }
        }
    }
    {
        const int tid = opaque_tid();
        asm volatile("s_waitcnt vmcnt(0)" ::: "memory");
        __syncthreads();
        if (tid == 0) st[4] = (xb_add(&g_ctl[CW_DONE], 1u) == (unsigned)(G - 1)) ? 1u : 0u;
        __syncthreads();
        if (st[4]) { for (int i = tid; i < CTL_WORDS; i += NTHREADS) __hip_atomic_store(&g_ctl[i], 0u, __ATOMIC_RELAXED, __HIP_MEMORY_SCOPE_AGENT); }
    }
}

extern "C" void kernel_launch(void* const* d_in, const int* in_sizes, int n_in, void* d_out, int out_size, void* d_ws, size_t ws_size, hipStream_t stream) {
    static int grid = 0;
    if (grid == 0) {
        int dev = 0, cus = 0, per_cu = 0;
        hipGetDevice(&dev);
        hipDeviceGetAttribute(&cus, hipDeviceAttributeMultiprocessorCount, dev);
        hipFuncSetAttribute((const void*)fwd_kernel, hipFuncAttributeMaxDynamicSharedMemorySize, LDS_BYTES);
        hipOccupancyMaxActiveBlocksPerMultiprocessor(&per_cu, (const void*)fwd_kernel, NTHREADS, LDS_BYTES);
        if (per_cu < 1) fprintf(stderr, "kernel_launch: occupancy query says %d blocks per CU\n", per_cu);
        grid = cus;
        (void)hipGetLastError();
    }
    Args a{};
    for (int i = 0; i < 12; ++i) a.in[i] = (const float*)d_in[i];
    a.out = (float*)d_out; a.ws = (unsigned char*)d_ws;
    void* args[] = {&a};
    hipError_t e = hipLaunchCooperativeKernel((const void*)fwd_kernel, dim3(grid), dim3(NTHREADS), args, LDS_BYTES, stream);
    if (e != hipSuccess) fprintf(stderr, "cooperative launch failed: %s (grid %d)\n", hipGetErrorString(e), grid);
}
```

```cpp
#include <hip/hip_runtime.h>
#include <hip/hip_cooperative_groups.h>
#include <cstdio>
#include <cstdint>
#include <type_traits>
namespace cg = cooperative_groups;
namespace pg8 {
#define PG8_LAS __attribute__((address_space(3)))
typedef unsigned short bf16_t;
typedef short bf16x8 __attribute__((ext_vector_type(8)));
typedef float f32x4 __attribute__((ext_vector_type(4)));
typedef unsigned u32x4 __attribute__((ext_vector_type(4)));
constexpr int BM = 256, BK = 64, HALF = 128, HTB = HALF * BK * 2  , STAGE_BYTES = 8 * HTB, NXCD = 8, WGM = 8;

__host__ __device__ __forceinline__ int lds_byte(int r, int c) { const int st = (r >> 4) * 2 + (c >> 5), rr = r & 15, cc = c & 31, ob = rr * 64 + cc * 2; return st * 1024 + (ob ^ (((ob >> 9) & 1) << 5)); }
__host__ __device__ __forceinline__ void stage_rc(int b, int& R, int& C) { const int st = b / 1024, sb = b % 1024, swz = sb ^ (((sb >> 9) & 1) << 5); R = (st >> 1) * 16 + swz / 64; C = (st & 1) * 32 + (swz % 64) / 2; }
__host__ __device__ __forceinline__ int perm32(int rho) { const int n = rho >> 4, i = rho & 15; return 8 * (i >> 2) + 4 * n + (i & 3); }

struct Unit { int pm, pn; };
struct Gemm { const bf16_t* A; const bf16_t* Bt; int M, N, K; };

struct StaticOrder {
    int nM, nN, nwg, G, c;
    __host__ __device__ void init(int M, int N, int G_, int c_) { nM = M / BM; nN = N / BM; nwg = nM * nN; G = G_; c = c_; }
    __host__ __device__ bool next(int i, Unit& u) const {
        const long L = (long)i * G + c; if (L >= nwg) return false;
        int wgid = (int)L; { const int q = nwg / NXCD, r = nwg % NXCD, xcd = wgid % NXCD, off = wgid / NXCD; wgid = (xcd < r ? xcd * (q + 1) : r * (q + 1) + (xcd - r) * q) + off; }
        const int nig = WGM * nN, gid = wgid / nig, fm = gid * WGM, gsz = (nM - fm) < WGM ? (nM - fm) : WGM;
        u.pm = fm + ((wgid % nig) % gsz); u.pn = (wgid % nig) / gsz; return true;
    }
    __device__ __forceinline__ void a_ready(const Unit&) const {}
    __device__ __forceinline__ void done(const Unit&) const {}
};

__device__ __forceinline__ unsigned cvt_pk_bf16(float lo, float hi) { unsigned r; asm volatile("v_cvt_pk_bf16_f32 %0, %1, %2" : "=v"(r) : "v"(lo), "v"(hi)); return r; }
template <class Epi, class Sched, bool ALIGN_EPI = false, bool SP2 = false>
__device__ __forceinline__ void gemm_phase(PG8_LAS unsigned char* lds, const Gemm g, const Sched& S, const Epi& E) {
    int tid_ = threadIdx.x; asm volatile("" : "+v"(tid_)); const int tid = tid_, wid = __builtin_amdgcn_readfirstlane(tid >> 6), lane = tid & 63, wr = wid >> 2, wc = wid & 3, fr = lane & 15, fq = lane >> 4;
    const int K = g.K, nt = K / BK;
    unsigned voffA[2], voffB[2];
#pragma unroll
    for (int i = 0; i < 2; ++i) { int R, C; stage_rc(tid * 16 + i * 8192, R, C); const int Rb = Epi::PERM ? ((R & ~31) + perm32(R & 31)) : R;
        voffA[i] = (unsigned)(R * K + C) * 2u; voffB[i] = (unsigned)(Rb * K + C) * 2u; }
    const size_t kstep = (size_t)(BK * 2);
    const size_t hstep = (size_t)HALF * K * 2;
    const size_t tstep = 2 * hstep;
    const unsigned ldsw = (unsigned)wid * 1024u;
    const int aoff = lds_byte(wr * 64 + fr, fq * 8), boff = lds_byte(wc * 32 + fr, fq * 8);
#define PG8_SA(b, h) (((b) * 2 + (h)) * HTB)
#define PG8_SB(b, h) ((4 + (b) * 2 + (h)) * HTB)
#define PG8_STAGE(bufoff, gbase, voff) do { _Pragma("unroll") for (int _i = 0; _i < 2; ++_i) \
        __builtin_amdgcn_global_load_lds((const unsigned*)((const char*)(gbase) + (voff)[_i]), (PG8_LAS unsigned*)(lds + (bufoff) + ldsw + _i * 8192), 16, 0, 0); } while (0)
#define PG8_LDA(dst, b, h) do { _Pragma("unroll") for (int m = 0; m < 4; ++m) _Pragma("unroll") for (int k = 0; k < 2; ++k) dst[m][k] = *(const PG8_LAS bf16x8*)(lds + PG8_SA(b, h) + aoff + m * 2048 + k * 1024); } while (0)
#define PG8_LDB(dst, b, h) do { _Pragma("unroll") for (int n = 0; n < 2; ++n) _Pragma("unroll") for (int k = 0; k < 2; ++k) dst[n][k] = *(const PG8_LAS bf16x8*)(lds + PG8_SB(b, h) + boff + n * 2048 + k * 1024); } while (0)
#define PG8_MMA(ai, bj, At, Bt) do { __builtin_amdgcn_s_setprio(1); _Pragma("unroll") for (int m = 0; m < 4; ++m) _Pragma("unroll") for (int n = 0; n < 2; ++n) _Pragma("unroll") for (int k = 0; k < 2; ++k) \
        acc[ai][bj][m][n] = __builtin_amdgcn_mfma_f32_16x16x32_bf16(Bt[n][k], At[m][k], acc[ai][bj][m][n], 0, 0, 0); __builtin_amdgcn_s_setprio(0); } while (0)
#define PG8_WAIT_V(n) asm volatile("s_waitcnt vmcnt(" #n ")" ::: "memory")
#define PG8_WAIT_L(n) asm volatile("s_waitcnt lgkmcnt(" #n ")" ::: "memory")
#define PG8_BAR __builtin_amdgcn_s_barrier()
#define PG8_SCHED __builtin_amdgcn_sched_barrier(0)
    Unit cur, nxt; int ui = 0;
    if (!S.next(0, cur)) return;
    f32x4 acc[2][2][4][2];
#pragma unroll
    for (int a = 0; a < 2; ++a)
#pragma unroll
        for (int b = 0; b < 2; ++b)
#pragma unroll
            for (int m = 0; m < 4; ++m)
#pragma unroll
                for (int n = 0; n < 2; ++n) acc[a][b][m][n] = (f32x4){0.f, 0.f, 0.f, 0.f};
    bf16x8 At[4][2], B0[2][2], B1[2][2];
    const char* cA = (const char*)g.A + (size_t)cur.pm * tstep; const char* cB = (const char*)g.Bt + (size_t)cur.pn * tstep;
    S.a_ready(cur);
    if constexpr (SP2) {
        PG8_STAGE(PG8_SB(0, 0), cB, voffB); PG8_STAGE(PG8_SB(0, 1), cB + hstep, voffB); PG8_STAGE(PG8_SA(0, 0), cA, voffA); PG8_STAGE(PG8_SA(0, 1), cA + hstep, voffA);
        if (wr == 1) PG8_BAR;
        PG8_WAIT_V(2); PG8_BAR;
        PG8_STAGE(PG8_SB(1, 0), cB + kstep, voffB); PG8_STAGE(PG8_SA(1, 0), cA + kstep, voffA); PG8_STAGE(PG8_SB(1, 1), cB + hstep + kstep, voffB);
        PG8_WAIT_V(6); PG8_BAR;
    } else {
        PG8_STAGE(PG8_SB(0, 0), cB, voffB); PG8_STAGE(PG8_SA(0, 0), cA, voffA); PG8_STAGE(PG8_SB(0, 1), cB + hstep, voffB); PG8_STAGE(PG8_SA(0, 1), cA + hstep, voffA);
        if (wr == 1) PG8_BAR;
        PG8_WAIT_V(4); PG8_BAR;
        PG8_STAGE(PG8_SB(1, 0), cB + kstep, voffB); PG8_STAGE(PG8_SA(1, 0), cA + kstep, voffA); PG8_STAGE(PG8_SB(1, 1), cB + hstep + kstep, voffB);
        PG8_WAIT_V(6); PG8_BAR;
    }
    for (;;) {
        const bool has_next = S.next(ui + 1, nxt);
        const char* nA = has_next ? (const char*)g.A + (size_t)nxt.pm * tstep : cA; const char* nB = has_next ? (const char*)g.Bt + (size_t)nxt.pn * tstep : cB;
        for (int t = 0; t < nt; t += 2) {
            const bool last = (t == nt - 2);
            const char* a1 = cA + (size_t)(t + 1) * kstep;
            const char* a2 = last ? nA : cA + (size_t)(t + 2) * kstep; const char* b2 = last ? nB : cB + (size_t)(t + 2) * kstep;
            const char* a3 = a2 + kstep; const char* b3 = b2 + kstep;
            if (last && has_next) S.a_ready(nxt);
            if constexpr (SP2) {
            PG8_LDB(B0, 0, 0); PG8_LDB(B1, 0, 1); PG8_SCHED; PG8_LDA(At, 0, 0); PG8_STAGE(PG8_SA(1, 1), a1 + hstep, voffA);
            PG8_WAIT_V(8); PG8_WAIT_L(0); PG8_BAR; PG8_MMA(0, 0, At, B0); PG8_MMA(0, 1, At, B1); PG8_BAR; PG8_SCHED;
            PG8_LDA(At, 0, 1); PG8_STAGE(PG8_SB(0, 0), b2, voffB); PG8_STAGE(PG8_SB(0, 1), b2 + hstep, voffB); PG8_STAGE(PG8_SA(0, 0), a2, voffA);
            PG8_WAIT_V(8); PG8_WAIT_L(0); PG8_BAR; PG8_MMA(1, 0, At, B0); PG8_MMA(1, 1, At, B1); PG8_BAR; PG8_SCHED;
            PG8_LDB(B0, 1, 0); PG8_LDB(B1, 1, 1); PG8_SCHED; PG8_LDA(At, 1, 0); PG8_STAGE(PG8_SA(0, 1), a2 + hstep, voffA);
            PG8_WAIT_V(8); PG8_WAIT_L(0); PG8_BAR; PG8_MMA(0, 0, At, B0); PG8_MMA(0, 1, At, B1); PG8_BAR; PG8_SCHED;
            PG8_LDA(At, 1, 1); PG8_STAGE(PG8_SB(1, 0), b3, voffB); PG8_STAGE(PG8_SB(1, 1), b3 + hstep, voffB); PG8_STAGE(PG8_SA(1, 0), a3, voffA);
            PG8_WAIT_V(8); PG8_WAIT_L(0); PG8_BAR; PG8_MMA(1, 0, At, B0); PG8_MMA(1, 1, At, B1); PG8_BAR; PG8_SCHED;
            } else {
            PG8_LDB(B0, 0, 0); PG8_SCHED; PG8_LDA(At, 0, 0); PG8_STAGE(PG8_SA(1, 1), a1 + hstep, voffA);
            PG8_WAIT_L(8); PG8_BAR; PG8_WAIT_L(0); PG8_MMA(0, 0, At, B0); PG8_BAR; PG8_SCHED;
            PG8_LDB(B1, 0, 1); PG8_STAGE(PG8_SB(0, 0), b2, voffB);
            PG8_BAR; PG8_WAIT_L(0); PG8_MMA(0, 1, At, B1); PG8_BAR;
            PG8_LDA(At, 0, 1); PG8_STAGE(PG8_SA(0, 0), a2, voffA);
            PG8_BAR; PG8_WAIT_L(0); PG8_MMA(1, 0, At, B0); PG8_BAR; PG8_SCHED;
            PG8_STAGE(PG8_SB(0, 1), b2 + hstep, voffB);
            PG8_WAIT_V(6); PG8_BAR; PG8_MMA(1, 1, At, B1); PG8_BAR;
            PG8_LDB(B0, 1, 0); PG8_SCHED; PG8_LDA(At, 1, 0); PG8_STAGE(PG8_SA(0, 1), a2 + hstep, voffA);
            PG8_WAIT_L(8); PG8_BAR; PG8_WAIT_L(0); PG8_MMA(0, 0, At, B0); PG8_BAR; PG8_SCHED;
            PG8_LDB(B1, 1, 1); PG8_STAGE(PG8_SB(1, 0), b3, voffB);
            PG8_BAR; PG8_WAIT_L(0); PG8_MMA(0, 1, At, B1); PG8_BAR;
            PG8_LDA(At, 1, 1); PG8_STAGE(PG8_SA(1, 0), a3, voffA);
            PG8_BAR; PG8_WAIT_L(0); PG8_MMA(1, 0, At, B0); PG8_BAR; PG8_SCHED;
            PG8_STAGE(PG8_SB(1, 1), b3 + hstep, voffB);
            PG8_WAIT_V(6); PG8_BAR; PG8_MMA(1, 1, At, B1); PG8_BAR;
            }
        }
        if constexpr (ALIGN_EPI) { if (wr == 0) PG8_BAR; }
        if constexpr (!Epi::AFTER_DRAIN) { E(acc, cur, wr, wc, fr, fq); S.done(cur); }
        if (!has_next) break;
#pragma unroll
        for (int a = 0; a < 2; ++a)
#pragma unroll
            for (int b = 0; b < 2; ++b)
#pragma unroll
                for (int m = 0; m < 4; ++m)
#pragma unroll
                    for (int n = 0; n < 2; ++n) acc[a][b][m][n] = (f32x4){0.f, 0.f, 0.f, 0.f};
        cur = nxt; cA = nA; cB = nB; ++ui;
        if constexpr (ALIGN_EPI) { if (wr == 1) PG8_BAR; }
    }
    PG8_WAIT_V(0);
    if constexpr (!ALIGN_EPI) { if (wr == 0) PG8_BAR; }
    PG8_BAR;
    if constexpr (Epi::AFTER_DRAIN) { E.fused(acc, cur, wr, wc, fr, fq, lds, wid, lane); S.done(cur); }
#undef PG8_SA
#undef PG8_SB
#undef PG8_STAGE
#undef PG8_LDA
#undef PG8_LDB
#undef PG8_MMA
#undef PG8_WAIT_V
#undef PG8_WAIT_L
#undef PG8_BAR
#undef PG8_SCHED
}
}

#define DI __device__ __forceinline__
typedef unsigned short bf16_t;
typedef short bf16x8 __attribute__((ext_vector_type(8)));
typedef short s16x4 __attribute__((ext_vector_type(4)));
typedef float f32x4 __attribute__((ext_vector_type(4)));
typedef float f32x16 __attribute__((ext_vector_type(16)));
typedef unsigned u32x4 __attribute__((ext_vector_type(4)));
typedef unsigned u32x2 __attribute__((ext_vector_type(2)));
#define LAS __attribute__((address_space(3)))

#define XB_TMO      128
#define XB_XCNT(j)  (256  + 64 * (j))
#define XB_XSUB(j)  (1280 + 64 * (j))
#define XB_XGEN(j)  (2304 + 64 * (j))
#define XB_TOP      3328
#define XB_TOPGEN   3392
#define XCD_BAR_WORDS 3456
#define XB_SPIN_CAP (1u << 18)

__device__ __forceinline__ unsigned xb_ld(unsigned* p)              { return __hip_atomic_load(p, __ATOMIC_RELAXED, __HIP_MEMORY_SCOPE_AGENT); }
__device__ __forceinline__ unsigned xb_add(unsigned* p, unsigned v) { return __hip_atomic_fetch_add(p, v, __ATOMIC_RELAXED, __HIP_MEMORY_SCOPE_AGENT); }
__device__ __forceinline__ unsigned xb_xcc_id() { return (unsigned)__builtin_amdgcn_s_getreg((3 << 11) | 20) & 0xFu; }
#define XB_SPIN(cond, bar) do { unsigned _sp = 0; while (cond) { __builtin_amdgcn_s_sleep(1); \
    if ((++_sp & 255u) == 0u) { if (xb_ld(&(bar)[XB_TMO])) break; if (_sp > XB_SPIN_CAP) { atomicAdd(&(bar)[XB_TMO], 1u); break; } } } } while (0)

struct XcdBarrier {
    unsigned* bar; unsigned x;
    volatile LAS unsigned* st;
};

__device__ __forceinline__ XcdBarrier xcd_barrier_post(unsigned* bar, volatile LAS unsigned* st) {
    XcdBarrier b; b.bar = bar; b.x = xb_xcc_id(); b.st = st;
    if (threadIdx.x == 0) (void)xb_add(&bar[XB_XCNT(b.x)], 1u);
    return b;
}
__device__ __forceinline__ void xcd_barrier_complete(unsigned* bar, unsigned x, unsigned& nloc, unsigned& nx) {
    const unsigned G = gridDim.x * gridDim.y * gridDim.z;
    unsigned sum, cnt, mine, sp = 0u;
    for (;;) {
        sum = 0u; cnt = 0u; mine = 0u;
#pragma unroll
        for (unsigned j = 0; j < 16; ++j) { const unsigned c = xb_ld(&bar[XB_XCNT(j)]); sum += c; cnt += (c > 0u) ? 1u : 0u; mine = (j == x) ? c : mine; }
        if (sum == G) break;
        __builtin_amdgcn_s_sleep(1);
        if ((++sp & 255u) == 0u) { if (xb_ld(&bar[XB_TMO])) break; if (sp > XB_SPIN_CAP) { atomicAdd(&bar[XB_TMO], 1u); break; } }
    }
    nloc = mine > 0u ? mine : 1u; nx = cnt > 0u ? cnt : 1u;
}

__device__ __forceinline__ void xcd_barrier(const XcdBarrier& b) {
    asm volatile("s_waitcnt vmcnt(0)" ::: "memory");
    __syncthreads();
    if (threadIdx.x == 0) {
        unsigned* bar = b.bar;
        __builtin_amdgcn_s_waitcnt(0);
        unsigned nloc = b.st[0], nx = b.st[1];
        if (nloc == 0u) { xcd_barrier_complete(bar, b.x, nloc, nx); b.st[0] = nloc; b.st[1] = nx; }
        const unsigned old = xb_add(&bar[XB_XSUB(b.x)], 1u);
        const unsigned gen = old / nloc;
        if (old + 1u == (gen + 1u) * nloc) {
            __builtin_amdgcn_fence(__ATOMIC_RELEASE, "agent");
            asm volatile("s_waitcnt vmcnt(0)" ::: "memory");
            const unsigned og = xb_add(&bar[XB_TOP], 1u);
            const unsigned tg = og / nx;
            if (og + 1u == (tg + 1u) * nx) xb_add(&bar[XB_TOPGEN], 1u);
            else XB_SPIN(xb_ld(&bar[XB_TOPGEN]) == tg, bar);
            __builtin_amdgcn_fence(__ATOMIC_ACQUIRE, "agent");
            xb_add(&bar[XB_XGEN(b.x)], 1u);
            asm volatile("s_waitcnt vmcnt(0)" ::: "memory");
        } else {
            XB_SPIN(xb_ld(&bar[XB_XGEN(b.x)]) == gen, bar);
            __builtin_amdgcn_fence(__ATOMIC_ACQUIRE, "agent");
            asm volatile("s_waitcnt vmcnt(0)" ::: "memory");
        }
    }
    __syncthreads();
}


constexpr int NTHREADS = 512;
constexpr int LDS_BYTES = 147456;
constexpr int M = 16384, DM = 1024, SEQ = 4096, NB = 4;
constexpr int DIN = 3848, NPAD = 4096, PW = 3840;
constexpr float EPS = 1e-6f;
constexpr float LOG2E = 1.4426950408889634f;
constexpr float C2 = 0.125f * LOG2E;

constexpr size_t MiB = 1u << 20;
constexpr size_t WS_WIN = 0;
constexpr size_t WS_WOUT = 16 * MiB;
constexpr size_t WS_SS = 20 * MiB;
constexpr size_t WS_LB = 20 * MiB + 512 * 1024;
constexpr size_t WS_FLOGT = 21 * MiB;
constexpr size_t WS_DD = 22 * MiB;
constexpr size_t WS_CTL = 23 * MiB, CTL_BYTES = 65536;
constexpr size_t WS_U = 24 * MiB;
constexpr size_t WS_XB = 32 * MiB;
constexpr size_t WS_Y = 64 * MiB;
constexpr size_t WS_LOGF = 96 * MiB;
constexpr size_t WS_P = 112 * MiB;
constexpr size_t WS_SB = 232 * MiB;
constexpr int CW_PANEL = 8192;
constexpr int CW_HU = 3584;

struct Args { const float* in[12]; float* out; unsigned char* ws; };

constexpr int CTL_WORDS = 16384, CW_DONE = 16000;
__device__ unsigned g_ctl[CTL_WORDS];

struct Ctx {
    const float *x, *norm_g, *w_in, *w_out, *ln_g, *ln_b, *w_s, *b_s, *hlb, *og, *bf, *gfin;
    float* out;
    bf16_t *WinT, *WoutT, *XB, *Y, *P;
    float *SS, *LB, *FLOGT, *DD, *U, *LOGF;
    bf16_t* SB; unsigned* ctl;
};

DI const void* karg_ptr(int byte_off) {
    const __attribute__((address_space(1))) void* p;
    asm volatile("s_load_dwordx2 %0, %1, %2\n\ts_waitcnt lgkmcnt(0)" : "=s"(p) : "s"(__builtin_amdgcn_kernarg_segment_ptr()), "i"(byte_off) : "memory");
    return (const void*)p;
}
#define KARG(i) karg_ptr((i) * 8)
DI Ctx load_ctx() {
    Ctx c;
    c.x = (const float*)KARG(0); c.norm_g = (const float*)KARG(1); c.w_in = (const float*)KARG(2); c.w_out = (const float*)KARG(3);
    c.ln_g = (const float*)KARG(4); c.ln_b = (const float*)KARG(5); c.w_s = (const float*)KARG(6); c.b_s = (const float*)KARG(7);
    c.hlb = (const float*)KARG(8); c.og = (const float*)KARG(9); c.bf = (const float*)KARG(10); c.gfin = (const float*)KARG(11);
    c.out = (float*)KARG(12);
    unsigned char* ws = (unsigned char*)KARG(13);
    c.WinT = (bf16_t*)(ws + WS_WIN); c.WoutT = (bf16_t*)(ws + WS_WOUT); c.XB = (bf16_t*)(ws + WS_XB); c.Y = (bf16_t*)(ws + WS_Y); c.P = (bf16_t*)(ws + WS_P);
    c.SS = (float*)(ws + WS_SS); c.LB = (float*)(ws + WS_LB); c.FLOGT = (float*)(ws + WS_FLOGT); c.DD = (float*)(ws + WS_DD); c.U = (float*)(ws + WS_U); c.LOGF = (float*)(ws + WS_LOGF);
    c.SB = (bf16_t*)(ws + WS_SB); c.ctl = g_ctl;
    return c;
}

DI int opaque_tid() { int t = threadIdx.x; asm volatile("" : "+v"(t)); return t; }
DI float bf2f(bf16_t b) { return __uint_as_float(((unsigned)b) << 16); }
typedef float f32x2_t __attribute__((ext_vector_type(2)));
typedef __bf16 bf16x2_t __attribute__((ext_vector_type(2)));
DI unsigned pk2(float lo, float hi) { const f32x2_t v = {lo, hi}; const bf16x2_t b = __builtin_convertvector(v, bf16x2_t); return __builtin_bit_cast(unsigned, b); }
DI unsigned f2bf(float f) { return pk2(f, 0.f) & 0xffffu; }
DI float lo_f(unsigned w) { return __uint_as_float(w << 16); }
DI float hi_f(unsigned w) { return __uint_as_float(w & 0xffff0000u); }
DI float wave_sum(float v) {
#pragma unroll
    for (int o = 1; o < 64; o <<= 1) v += __shfl_xor(v, o);
    return v;
}
DI float rcp_(float x) { return __builtin_amdgcn_rcpf(x); }
DI float ex2_(float x) { return __builtin_amdgcn_exp2f(x); }
DI float sigmoidf_(float z) { return rcp_(1.f + ex2_(-LOG2E * z)); }
DI float siluf_(float z) { return z * rcp_(1.f + ex2_(-LOG2E * z)); }
DI float geluf_(float x) { const float u = 0.7978845608028654f * (x + 0.044715f * x * x * x); return x * rcp_(1.f + ex2_(-2.f * LOG2E * u)); }
#define MFMA16(a, b, c) __builtin_amdgcn_mfma_f32_16x16x32_bf16((a), (b), (c), 0, 0, 0)
#define MFMA32(a, b, c) __builtin_amdgcn_mfma_f32_32x32x16_bf16((a), (b), (c), 0, 0, 0)

struct EpiIn {
    static constexpr bool PERM = true, AFTER_DRAIN = false;
    bf16_t* P; float* LOGF; float* FLOGT; const float* ss; const float* lb; const float* bfl;
    DI void operator()(const f32x4 (&acc)[2][2][4][2], const pg8::Unit& u, int wr, int wc, int fr, int fq) const {
        const int pn = u.pn;
        const int rowb = u.pm * 256 + wr * 64 + fr;
        float rsv[2][4];
#pragma unroll
        for (int ai = 0; ai < 2; ++ai)
#pragma unroll
            for (int m = 0; m < 4; ++m) rsv[ai][m] = ss[rowb + ai * 128 + m * 16];
#pragma unroll
        for (int ai = 0; ai < 2; ++ai)
#pragma unroll
            for (int m = 0; m < 4; ++m) rsv[ai][m] = rsqrtf(rsv[ai][m] * (1.f / DM) + EPS);
        if (pn == 15) {
            if (wc == 0 && fq == 0) {
#pragma unroll
                for (int ai = 0; ai < 2; ++ai)
#pragma unroll
                    for (int m = 0; m < 4; ++m) {
                        const int row = rowb + ai * 128 + m * 16;
                        const float rs = rsv[ai][m];
                        const int b = row >> 12, s = row & 4095;
#pragma unroll
                        for (int n = 0; n < 2; ++n)
#pragma unroll
                            for (int i = 0; i < 4; ++i) {
                                const int h = 4 * n + i;
                                const float t = acc[ai][0][m][n][i] * rs + bfl[h];
                                const float ls = fminf(t, 0.f) - log1pf(expf(-fabsf(t)));
                                FLOGT[(size_t)(b * 8 + h) * SEQ + s] = ls * LOG2E;
                            }
                    }
            }
            return;
        }
        int mode = 0; float scale = 1.f;
        if (pn <= 1) mode = 1;
        else if (pn == 2 || pn == 6 || pn >= 13) mode = 2;
        else if (pn == 3) { mode = 2; scale = 0.125f; }
        else if (pn == 4) mode = 3;
        else if (pn == 7 || pn == 8) scale = C2;
        const int cl = wc * 32 + 8 * fq;
#pragma unroll
        for (int ai = 0; ai < 2; ++ai)
#pragma unroll
            for (int m = 0; m < 4; ++m) {
                const int row = rowb + ai * 128 + m * 16;
                const float rs = rsv[ai][m];
#pragma unroll
                for (int bj = 0; bj < 2; ++bj) {
                    const int ct = bj * 128 + cl;
                    float v[8];
#pragma unroll
                    for (int i = 0; i < 4; ++i) { v[i] = acc[ai][bj][m][0][i] * rs; v[4 + i] = acc[ai][bj][m][1][i] * rs; }
                    if (mode == 1) {
#pragma unroll
                        for (int i = 0; i < 8; ++i) v[i] = geluf_(v[i]);
                    } else if (mode == 2) {
#pragma unroll
                        for (int i = 0; i < 8; ++i) v[i] = siluf_(v[i]) * scale;
                    } else if (mode == 3) {
                        float lf[8];
#pragma unroll
                        for (int i = 0; i < 8; ++i) {
                            const float l = lb[ct + i], z = v[i];
                            const float sg = sigmoidf_(z);
                            const float f = l + (1.f - l) * sg;
                            lf[i] = __logf(fmaxf(f, 1e-30f));
                            v[i] = (1.f - l) * sigmoidf_(-z);
                        }
                        float* lp = LOGF + (size_t)row * 256 + ct;
                        *(f32x4*)lp = (f32x4){lf[0], lf[1], lf[2], lf[3]};
                        *(f32x4*)(lp + 4) = (f32x4){lf[4], lf[5], lf[6], lf[7]};
                    } else {
#pragma unroll
                        for (int i = 0; i < 8; ++i) v[i] *= scale;
                    }
                    u32x4 w; w.x = pk2(v[0], v[1]); w.y = pk2(v[2], v[3]); w.z = pk2(v[4], v[5]); w.w = pk2(v[6], v[7]);
                    *(u32x4*)(P + (size_t)row * PW + pn * 256 + ct) = w;
                }
            }
    }
};

struct EpiOut {
    static constexpr bool PERM = true, AFTER_DRAIN = false;
    const float* xin; float* xout; bf16_t* XB; float* ssn;
    DI void operator()(const f32x4 (&acc)[2][2][4][2], const pg8::Unit& u, int wr, int wc, int fr, int fq) const {
        const int rowb = u.pm * 256 + wr * 64 + fr;
        const int cb = u.pn * 256 + wc * 32 + 8 * fq;
#pragma unroll
        for (int ai = 0; ai < 2; ++ai) {
            f32x4 xv[4][2][2];
#pragma unroll
            for (int m = 0; m < 4; ++m)
#pragma unroll
                for (int bj = 0; bj < 2; ++bj) {
                    const size_t o = (size_t)(rowb + ai * 128 + m * 16) * DM + cb + bj * 128;
                    xv[m][bj][0] = __builtin_nontemporal_load((const f32x4*)(xin + o)); xv[m][bj][1] = __builtin_nontemporal_load((const f32x4*)(xin + o + 4));
                }
#pragma unroll
            for (int m = 0; m < 4; ++m) {
                const int row = rowb + ai * 128 + m * 16;
                float sq = 0.f;
#pragma unroll
                for (int bj = 0; bj < 2; ++bj) {
                    const size_t o = (size_t)row * DM + cb + bj * 128;
                    f32x4 x0 = xv[m][bj][0], x1 = xv[m][bj][1];
                    x0 = x0 + acc[ai][bj][m][0]; x1 = x1 + acc[ai][bj][m][1];
                    *(f32x4*)(xout + o) = x0; *(f32x4*)(xout + o + 4) = x1;
                    u32x4 w; w.x = pk2(x0[0], x0[1]); w.y = pk2(x0[2], x0[3]); w.z = pk2(x1[0], x1[1]); w.w = pk2(x1[2], x1[3]);
                    *(u32x4*)(XB + o) = w;
                    sq += x0[0] * x0[0] + x0[1] * x0[1] + x0[2] * x0[2] + x0[3] * x0[3] + x1[0] * x1[0] + x1[1] * x1[1] + x1[2] * x1[2] + x1[3] * x1[3];
                }
                sq += __shfl_xor(sq, 16); sq += __shfl_xor(sq, 32);
                if (fq == 0) atomicAdd(ssn + row, sq);
            }
        }
    }
};

struct EpiOutFinal {
    static constexpr bool PERM = true, AFTER_DRAIN = false;
    const float* xin; float* out; float* ss; unsigned* pcnt; const float* gf;
    DI void operator()(const f32x4 (&acc_)[2][2][4][2], const pg8::Unit& u, int wr, int wc, int fr, int fq) const {
        f32x4 (&acc)[2][2][4][2] = const_cast<f32x4 (&)[2][2][4][2]>(acc_);
        const int rowb = u.pm * 256 + wr * 64 + fr;
        const int cb = u.pn * 256 + wc * 32 + 8 * fq;
#pragma unroll
        for (int ai = 0; ai < 2; ++ai)
#pragma unroll
            for (int m = 0; m < 4; ++m) {
                const int row = rowb + ai * 128 + m * 16;
                float sq = 0.f;
#pragma unroll
                for (int bj = 0; bj < 2; ++bj) {
                    const size_t o = (size_t)row * DM + cb + bj * 128;
                    const f32x4 x0 = __builtin_nontemporal_load((const f32x4*)(xin + o)) + acc[ai][bj][m][0], x1 = __builtin_nontemporal_load((const f32x4*)(xin + o + 4)) + acc[ai][bj][m][1];
                    acc[ai][bj][m][0] = x0; acc[ai][bj][m][1] = x1;
                    sq += x0[0] * x0[0] + x0[1] * x0[1] + x0[2] * x0[2] + x0[3] * x0[3] + x1[0] * x1[0] + x1[1] * x1[1] + x1[2] * x1[2] + x1[3] * x1[3];
                }
                sq += __shfl_xor(sq, 16); sq += __shfl_xor(sq, 32);
                if (fq == 0) atomicAdd(ss + row, sq);
            }
        asm volatile("s_waitcnt vmcnt(0)" ::: "memory");
        __syncthreads();
        if (threadIdx.x == 0) {
            __builtin_amdgcn_fence(__ATOMIC_RELEASE, "agent"); asm volatile("s_waitcnt vmcnt(0)" ::: "memory");
            unsigned* pc = pcnt + 64 * u.pm;
            xb_add(pc, 1u);
            unsigned sp = 0;
            while (xb_ld(pc) < 4u) { __builtin_amdgcn_s_sleep(1); if (++sp > (1u << 22)) break; }
            __builtin_amdgcn_fence(__ATOMIC_ACQUIRE, "agent"); asm volatile("s_waitcnt vmcnt(0)" ::: "memory");
        }
        __syncthreads();
#pragma unroll
        for (int ai = 0; ai < 2; ++ai)
#pragma unroll
            for (int m = 0; m < 4; ++m) {
                const int row = rowb + ai * 128 + m * 16;
                const float rs = rsqrtf(__hip_atomic_load(ss + row, __ATOMIC_RELAXED, __HIP_MEMORY_SCOPE_AGENT) * (1.f / DM) + EPS);
#pragma unroll
                for (int bj = 0; bj < 2; ++bj) {
                    const int col = cb + bj * 128;
                    const f32x4 g0 = *(const f32x4*)(gf + col), g1 = *(const f32x4*)(gf + col + 4);
                    const size_t o = (size_t)row * DM + col;
                    *(f32x4*)(out + o) = acc[ai][bj][m][0] * rs * g0; *(f32x4*)(out + o + 4) = acc[ai][bj][m][1] * rs * g1;
                }
            }
    }
};

DI void transpose_item(const float* W, int N, bf16_t* WT, const float* g, int kb, int nb, float* scr, int lane) {
    const int k0 = 64 * kb, n0 = 64 * nb;
    const bool nok = (n0 + lane) < N;
    float v[64];
#pragma unroll
    for (int i = 0; i < 64; ++i) v[i] = nok ? __builtin_nontemporal_load(W + (size_t)(k0 + i) * N + n0 + lane) : 0.f;
    if (g) {
#pragma unroll
        for (int i = 0; i < 64; ++i) v[i] *= g[k0 + i];
    }
#pragma unroll
    for (int i = 0; i < 64; ++i) scr[i * 65 + lane] = v[i];
    asm volatile("s_waitcnt lgkmcnt(0)" ::: "memory");
    const int cch = lane & 7;
#pragma unroll
    for (int j = 0; j < 8; ++j) {
        const int n = (lane >> 3) + 8 * j;
        const float* sp = scr + (8 * cch) * 65 + n;
        u32x4 o; o.x = pk2(sp[0], sp[65]); o.y = pk2(sp[2 * 65], sp[3 * 65]); o.z = pk2(sp[4 * 65], sp[5 * 65]); o.w = pk2(sp[6 * 65], sp[7 * 65]);
        if (n0 + n < N) *(u32x4*)(WT + (size_t)(n0 + n) * 1024 + k0 + 8 * cch) = o;
    }
    asm volatile("s_waitcnt lgkmcnt(0)" ::: "memory");
}

DI void prologue(const Ctx& c, int vcu, int G, unsigned char* lds) {
    const int tid = opaque_tid(), lane = tid & 63, wave = tid >> 6;
    const int gw = vcu * 8 + wave, NGW = G * 8;
    float* scr = (float*)lds + wave * (64 * 65);
#pragma unroll 8
    for (int r = vcu * 8 + wave; r < M; r += G * 8) {
        const f32x4* xr = (const f32x4*)(c.x + (size_t)r * DM) + lane;
        u32x2* o8 = (u32x2*)(c.XB + (size_t)r * DM) + lane;
        float s = 0.f;
#pragma unroll
        for (int j = 0; j < 4; ++j) { const f32x4 v = __builtin_nontemporal_load(xr + 64 * j); s += v[0] * v[0] + v[1] * v[1] + v[2] * v[2] + v[3] * v[3];
            o8[64 * j] = (u32x2){pk2(v[0], v[1]), pk2(v[2], v[3])}; }
        s = wave_sum(s);
        if (lane == 0) c.SS[r] = s;
    }
    constexpr int NB_IN = (DIN + 63) / 64, IT_IN = 16 * NB_IN, IT_OUT = 16 * 16;
    for (int it = gw; it < 2 * IT_IN + 2 * IT_OUT; it += NGW) {
        int r = it;
        if (r < 2 * IT_IN) { const int L = r / IT_IN; r -= L * IT_IN;
            transpose_item(c.w_in + (size_t)L * 1024 * DIN, DIN, c.WinT + (size_t)L * NPAD * 1024, c.norm_g + L * 1024, r / NB_IN, r % NB_IN, scr, lane); }
        else { r -= 2 * IT_IN; const int L = r / IT_OUT; r -= L * IT_OUT;
            transpose_item(c.w_out + (size_t)L * 1024 * 1024, 1024, c.WoutT + (size_t)L * 1024 * 1024, nullptr, r / 16, r % 16, scr, lane); }
    }
    for (int i = vcu * NTHREADS + tid; i < 2 * 248 * 128; i += G * NTHREADS) {
        const int L = i / (248 * 128), r = i % (248 * 128);
        *(u32x4*)(c.WinT + (size_t)L * NPAD * 1024 + (size_t)(DIN + r / 128) * 1024 + (r % 128) * 8) = (u32x4){0u, 0u, 0u, 0u};
    }
    for (int i = vcu * NTHREADS + tid; i < 2 * M; i += G * NTHREADS) c.SS[M + i] = 0.f;
    for (int i = vcu * NTHREADS + tid; i < 256; i += G * NTHREADS) {
        const float l0 = c.hlb[i], l1 = c.hlb[256 + i], mx = fmaxf(l0, l1);
        const float e0 = expf(l0 - mx), e1 = expf(l1 - mx);
        const float p0 = e0 / (e0 + e1), p1 = e1 / (e0 + e1);
        c.LB[i] = fminf(fmaxf(p0 - p0, 0.f), 1.f - 1e-6f);
        c.LB[256 + i] = fminf(fmaxf((p0 + p1) - p0, 0.f), 1.f - 1e-6f);
    }
}

DI void hgrn_cumsum(const float* LOGF, size_t row0, int h, float* segtot, float (&bl)[16], float& tot) {
    const int tid = opaque_tid(), k = tid & 63, seg = tid >> 6;
    const float* lf = LOGF + (row0 + seg * 16) * 256 + h * 64 + k;
    float run = 0.f;
#pragma unroll
    for (int i = 0; i < 16; ++i) { run += lf[(size_t)i * 256]; bl[i] = run; }
    segtot[seg * 64 + k] = run;
    __syncthreads();
    float off = 0.f; tot = 0.f;
#pragma unroll
    for (int s2 = 0; s2 < 8; ++s2) { const float v = segtot[s2 * 64 + k]; if (s2 < seg) off += v; tot += v; }
#pragma unroll
    for (int i = 0; i < 16; ++i) bl[i] += off;
}
DI void stage_colT(const bf16_t* P, size_t row0, int colbase, bf16_t* img) {
    const int tid = opaque_tid(), k = tid & 63, seg = tid >> 6;
    const bf16_t* p = P + (row0 + seg * 16) * PW + colbase + k;
    unsigned w[8];
#pragma unroll
    for (int i = 0; i < 8; ++i) w[i] = (unsigned)p[(size_t)(2 * i) * PW] | ((unsigned)p[(size_t)(2 * i + 1) * PW] << 16);
    u32x4* d = (u32x4*)(img + k * 136 + seg * 16);
    d[0] = (u32x4){w[0], w[1], w[2], w[3]}; d[1] = (u32x4){w[4], w[5], w[6], w[7]};
}

DI void hgrn_u_pair(const Ctx& c, int itA, int itB, unsigned char* lds, unsigned* cnt) {
    const int tid = opaque_tid(), lane = tid & 63, wave = tid >> 6, fr = lane & 15, fq = lane >> 4;
    const int k = tid & 63, seg = tid >> 6;
    const int items[2] = {itA, itB >= 0 ? itB : itA};
    constexpr int ISZ = 64 * 136 * 2 * 2 + 2048;
    float bl[2][16]; unsigned short kr[2][16];
    size_t row0[2]; int hh[2];
#pragma unroll
    for (int u = 0; u < 2; ++u) {
        const int item = items[u], b = item >> 7, h = (item >> 5) & 3, ch = item & 31;
        hh[u] = h; row0[u] = (size_t)b * SEQ + ch * 128;
        const float* lf = c.LOGF + (row0[u] + seg * 16) * 256 + h * 64 + k;
        const bf16_t* kp = c.P + (row0[u] + seg * 16) * PW + 1024 + h * 64 + k;
#pragma unroll
        for (int i = 0; i < 16; ++i) { bl[u][i] = lf[(size_t)i * 256]; kr[u][i] = kp[(size_t)i * PW]; }
    }
#pragma unroll
    for (int u = 0; u < 2; ++u) stage_colT(c.P, row0[u], 1280 + hh[u] * 64, (bf16_t*)(lds + u * ISZ) + 64 * 136);
#pragma unroll
    for (int u = 0; u < 2; ++u) {
        float* segtot = (float*)(lds + u * ISZ + 64 * 136 * 4);
        float run = 0.f;
#pragma unroll
        for (int i = 0; i < 16; ++i) { run += bl[u][i]; bl[u][i] = run; }
        segtot[seg * 64 + k] = run;
    }
    __syncthreads();
#pragma unroll
    for (int u = 0; u < 2; ++u) {
        const float* segtot = (const float*)(lds + u * ISZ + 64 * 136 * 4);
        bf16_t* kdT = (bf16_t*)(lds + u * ISZ);
        float off = 0.f, tot = 0.f;
#pragma unroll
        for (int s2 = 0; s2 < 8; ++s2) { const float v = segtot[s2 * 64 + k]; if (s2 < seg) off += v; tot += v; }
        const float tb = tot - off;
        unsigned w[8];
#pragma unroll
        for (int i = 0; i < 8; ++i)
            w[i] = pk2(bf2f(kr[u][2 * i]) * __expf(tb - bl[u][2 * i]), bf2f(kr[u][2 * i + 1]) * __expf(tb - bl[u][2 * i + 1]));
        u32x4* d = (u32x4*)(kdT + k * 136 + seg * 16);
        d[0] = (u32x4){w[0], w[1], w[2], w[3]}; d[1] = (u32x4){w[4], w[5], w[6], w[7]};
        if (seg == 0) c.DD[(size_t)items[u] * 64 + k] = __expf(tot);
    }
    __syncthreads();
    const int mt = wave >> 1, nt0 = (wave & 1) * 2;
#pragma unroll
    for (int u = 0; u < 2; ++u) {
        const bf16_t* kdT = (const bf16_t*)(lds + u * ISZ);
        const bf16_t* vT = kdT + 64 * 136;
        f32x4 acc[2] = {(f32x4){0.f, 0.f, 0.f, 0.f}, (f32x4){0.f, 0.f, 0.f, 0.f}};
#pragma unroll
        for (int ks = 0; ks < 4; ++ks) {
            const bf16x8 A = *(const bf16x8*)(kdT + (mt * 16 + fr) * 136 + ks * 32 + fq * 8);
#pragma unroll
            for (int n2 = 0; n2 < 2; ++n2) {
                const bf16x8 B = *(const bf16x8*)(vT + ((nt0 + n2) * 16 + fr) * 136 + ks * 32 + fq * 8);
                acc[n2] = MFMA16(A, B, acc[n2]);
            }
        }
        float* Up = c.U + (size_t)items[u] * 4096;
#pragma unroll
        for (int n2 = 0; n2 < 2; ++n2) *(f32x4*)(Up + ((nt0 + n2) * 16 + fr) * 64 + mt * 16 + fq * 4) = acc[n2];
    }
    asm volatile("s_waitcnt vmcnt(0)" ::: "memory");
    __syncthreads();
    if (tid == 0) { __builtin_amdgcn_fence(__ATOMIC_RELEASE, "agent"); asm volatile("s_waitcnt vmcnt(0)" ::: "memory"); xb_add(cnt, itB >= 0 ? 2u : 1u); }
}

DI void gmlp_pair(const Ctx& c, int L, int itA, int itB, unsigned char* lds) {
    const int tid = opaque_tid(), lane = tid & 63, wave = tid >> 6, fr = lane & 15, fq = lane >> 4;
    const int items[2] = {itA, itB >= 0 ? itB : itA};
    constexpr int VS = 136;
    size_t row0[2]; int gg[2];
    u32x4 w0[2], w1[2];
#pragma unroll
    for (int u = 0; u < 2; ++u) {
        const int item = items[u], b = item >> 7, n = (item >> 2) & 31, g = item & 3;
        gg[u] = g; row0[u] = (size_t)b * SEQ + n * 128;
        const bf16_t* src = c.P + (row0[u] + (tid >> 2)) * PW + 256 + g * 64 + (tid & 3) * 16;
        w0[u] = *(const u32x4*)src; w1[u] = *(const u32x4*)(src + 8);
    }
    unsigned short gur[2][4][4], szr[2][4][4];
#pragma unroll
    for (int u = 0; u < 2; ++u)
#pragma unroll
        for (int nt = 0; nt < 4; ++nt)
#pragma unroll
            for (int reg = 0; reg < 4; ++reg) {
                const size_t row = row0[u] + wave * 16 + fq * 4 + reg; const int cc = gg[u] * 64 + nt * 16 + fr;
                gur[u][nt][reg] = c.P[row * PW + cc]; szr[u][nt][reg] = c.P[row * PW + 512 + cc];
            }
#pragma unroll
    for (int u = 0; u < 2; ++u) {
        bf16_t* vnT = (bf16_t*)lds + u * 64 * VS;
        const int s = tid >> 2, part = tid & 3, g = gg[u];
        float x[16];
#pragma unroll
        for (int i = 0; i < 4; ++i) { x[2 * i] = lo_f(w0[u][i]); x[2 * i + 1] = hi_f(w0[u][i]); x[8 + 2 * i] = lo_f(w1[u][i]); x[8 + 2 * i + 1] = hi_f(w1[u][i]); }
        float sum = 0.f;
#pragma unroll
        for (int i = 0; i < 16; ++i) sum += x[i];
        sum += __shfl_xor(sum, 1); sum += __shfl_xor(sum, 2);
        const float mean = sum * (1.f / 64.f);
        float sq = 0.f;
#pragma unroll
        for (int i = 0; i < 16; ++i) { x[i] -= mean; sq += x[i] * x[i]; }
        sq += __shfl_xor(sq, 1); sq += __shfl_xor(sq, 2);
        const float rstd = rsqrtf(sq * (1.f / 64.f) + EPS);
        const float* lg = c.ln_g + L * 256 + g * 64 + part * 16;
        const float* lbp = c.ln_b + L * 256 + g * 64 + part * 16;
#pragma unroll
        for (int i = 0; i < 16; ++i) vnT[(part * 16 + i) * VS + s] = (bf16_t)f2bf(x[i] * rstd * lg[i] + lbp[i]);
    }
    __syncthreads();
    const int t = wave * 16 + fr;
    const int ksmax = (wave * 16 + 15) >> 5;
#pragma unroll
    for (int u = 0; u < 2; ++u) {
        const bf16_t* vnT = (const bf16_t*)lds + u * 64 * VS;
        const int g = gg[u];
        f32x4 acc[4];
#pragma unroll
        for (int i = 0; i < 4; ++i) acc[i] = (f32x4){0.f, 0.f, 0.f, 0.f};
        const float* wrow = c.w_s + ((size_t)(L * 4 + g) * 128 + t) * 128;
        for (int ks = 0; ks <= ksmax; ++ks) {
            const int s0 = ks * 32 + fq * 8;
            const f32x4 wa = *(const f32x4*)(wrow + s0), wb = *(const f32x4*)(wrow + s0 + 4);
            float wv[8] = {wa[0], wa[1], wa[2], wa[3], wb[0], wb[1], wb[2], wb[3]};
#pragma unroll
            for (int j = 0; j < 8; ++j) if (s0 + j > t) wv[j] = 0.f;
            u32x4 aw; aw.x = pk2(wv[0], wv[1]); aw.y = pk2(wv[2], wv[3]); aw.z = pk2(wv[4], wv[5]); aw.w = pk2(wv[6], wv[7]);
            const bf16x8 A = __builtin_bit_cast(bf16x8, aw);
#pragma unroll
            for (int nt = 0; nt < 4; ++nt) {
                const bf16x8 B = *(const bf16x8*)(vnT + (nt * 16 + fr) * VS + s0);
                acc[nt] = MFMA16(A, B, acc[nt]);
            }
        }
        const float* bsp = c.b_s + (size_t)(L * 4 + g) * 128 + wave * 16 + fq * 4;
#pragma unroll
        for (int nt = 0; nt < 4; ++nt) {
            const int cc = g * 64 + nt * 16 + fr;
#pragma unroll
            for (int reg = 0; reg < 4; ++reg) {
                const size_t row = row0[u] + wave * 16 + fq * 4 + reg;
                const float mixed = acc[nt][reg] + bsp[reg];
                c.Y[row * DM + cc] = (bf16_t)f2bf(bf2f(gur[u][nt][reg]) * mixed * bf2f(szr[u][nt][reg]));
            }
        }
    }
    __syncthreads();
}

DI void hgrn_scan_item(const Ctx& c, int item, unsigned* cnt) {
    const int tid = opaque_tid();
    if (tid == 0) {
        unsigned sp = 0;
        while (xb_ld(cnt) < 512u) { __builtin_amdgcn_s_sleep(1); if (++sp > (1u << 22)) break; }
        __builtin_amdgcn_fence(__ATOMIC_ACQUIRE, "agent");
        asm volatile("s_waitcnt vmcnt(0)" ::: "memory");
    }
    __syncthreads();
    const int bhh = item >> 1, vh = item & 1;
    const int v = vh * 32 + (tid >> 4), k4 = (tid & 15) * 4;
    const float* Ub = c.U + (size_t)bhh * 32 * 4096 + v * 64 + k4;
    const float* Db = c.DD + (size_t)bhh * 32 * 64 + k4;
    bf16_t* Sb = c.SB + (size_t)bhh * 32 * 4096 + v * 64 + k4;
    f32x4 S = (f32x4){0.f, 0.f, 0.f, 0.f};
    for (int j0 = 0; j0 < 32; j0 += 8) {
        f32x4 u[8], d[8];
#pragma unroll
        for (int j = 0; j < 8; ++j) { u[j] = *(const f32x4*)(Ub + (size_t)(j0 + j) * 4096); d[j] = *(const f32x4*)(Db + (size_t)(j0 + j) * 64); }
#pragma unroll
        for (int j = 0; j < 8; ++j) {
            *(u32x2*)(Sb + (size_t)(j0 + j) * 4096) = (u32x2){pk2(S[0], S[1]), pk2(S[2], S[3])};
            S = d[j] * S + u[j];
        }
    }
}

DI void hgrn_o_item(const Ctx& c, int L, int item, unsigned char* lds) {
    const int tid = opaque_tid(), lane = tid & 63, wave = tid >> 6, fr = lane & 15, fq = lane >> 4;
    const int b = item >> 7, h = (item >> 5) & 3, ch = item & 31;
    const size_t row0 = (size_t)b * SEQ + ch * 128;
    bf16_t* qs = (bf16_t*)lds;
    bf16_t* ks_ = qs + 128 * 72;
    float* bs = (float*)(ks_ + 128 * 72);
    bf16_t* vT = (bf16_t*)(bs + 128 * 68);
    bf16_t* ST = vT + 64 * 136;
    bf16_t* Ab = ST + 64 * 72;
    float* segtot = (float*)(Ab + 8 * 16 * 136);
    const int k = tid & 63, seg = tid >> 6;
    const u32x4 sbv = *(const u32x4*)(c.SB + (size_t)item * 4096 + (tid >> 3) * 64 + (tid & 7) * 8);
    float bl[16]; unsigned short vr[16];
    {
        const float* lf = c.LOGF + (row0 + seg * 16) * 256 + h * 64 + k;
        const bf16_t* vp = c.P + (row0 + seg * 16) * PW + 1280 + h * 64 + k;
#pragma unroll
        for (int i = 0; i < 16; ++i) { bl[i] = lf[(size_t)i * 256]; vr[i] = vp[(size_t)i * PW]; }
    }
    u32x4 qv[2], kv[2];
#pragma unroll
    for (int i = 0; i < 2; ++i) {
        const int id = tid + 512 * i, t = id >> 3, cc = id & 7;
        qv[i] = *(const u32x4*)(c.P + (row0 + t) * PW + 768 + h * 64 + cc * 8);
        kv[i] = *(const u32x4*)(c.P + (row0 + t) * PW + 1024 + h * 64 + cc * 8);
    }
    unsigned short zg[4][4];
#pragma unroll
    for (int nt = 0; nt < 4; ++nt)
#pragma unroll
        for (int reg = 0; reg < 4; ++reg) zg[nt][reg] = c.P[(row0 + wave * 16 + 4 * fq + reg) * PW + 1536 + h * 64 + nt * 16 + fr];
    *(u32x4*)(ST + (tid >> 3) * 72 + (tid & 7) * 8) = sbv;
#pragma unroll
    for (int i = 0; i < 2; ++i) {
        const int id = tid + 512 * i, t = id >> 3, cc = id & 7;
        *(u32x4*)(qs + t * 72 + cc * 8) = qv[i];
        *(u32x4*)(ks_ + t * 72 + cc * 8) = kv[i];
    }
    {
        u32x4* d = (u32x4*)(vT + k * 136 + seg * 16);
        d[0] = (u32x4){(unsigned)vr[0] | ((unsigned)vr[1] << 16), (unsigned)vr[2] | ((unsigned)vr[3] << 16), (unsigned)vr[4] | ((unsigned)vr[5] << 16), (unsigned)vr[6] | ((unsigned)vr[7] << 16)};
        d[1] = (u32x4){(unsigned)vr[8] | ((unsigned)vr[9] << 16), (unsigned)vr[10] | ((unsigned)vr[11] << 16), (unsigned)vr[12] | ((unsigned)vr[13] << 16), (unsigned)vr[14] | ((unsigned)vr[15] << 16)};
    }
    {
        float run = 0.f;
#pragma unroll
        for (int i = 0; i < 16; ++i) { run += bl[i]; bl[i] = run; }
        segtot[seg * 64 + k] = run;
    }
    __syncthreads();
    {
        float off = 0.f;
#pragma unroll
        for (int s2 = 0; s2 < 8; ++s2) { const float v = segtot[s2 * 64 + k]; if (s2 < seg) off += v; }
#pragma unroll
        for (int i = 0; i < 16; ++i) bs[(seg * 16 + i) * 68 + k] = bl[i] + off;
    }
    __syncthreads();
    const int w = wave;
    const float* brow = bs + (w * 16 + fr) * 68;
    const float* rho = bs + (w * 16) * 68;
    bf16x8 Aq[2], Aqs[2];
#pragma unroll
    for (int k2 = 0; k2 < 2; ++k2) {
        const int k0 = k2 * 32 + fq * 8;
        const u32x4 qw = *(const u32x4*)(qs + (w * 16 + fr) * 72 + k0);
        const f32x4 b0 = *(const f32x4*)(brow + k0), b1 = *(const f32x4*)(brow + k0 + 4);
        const f32x4 r0 = *(const f32x4*)(rho + k0), r1 = *(const f32x4*)(rho + k0 + 4);
        float q[8] = {lo_f(qw[0]), hi_f(qw[0]), lo_f(qw[1]), hi_f(qw[1]), lo_f(qw[2]), hi_f(qw[2]), lo_f(qw[3]), hi_f(qw[3])};
        float bb[8] = {b0[0], b0[1], b0[2], b0[3], b1[0], b1[1], b1[2], b1[3]};
        float rr[8] = {r0[0], r0[1], r0[2], r0[3], r1[0], r1[1], r1[2], r1[3]};
        u32x4 a, as;
#pragma unroll
        for (int j = 0; j < 4; ++j) {
            a[j] = pk2(q[2 * j] * __expf(bb[2 * j] - rr[2 * j]), q[2 * j + 1] * __expf(bb[2 * j + 1] - rr[2 * j + 1]));
            as[j] = pk2(q[2 * j] * __expf(bb[2 * j]), q[2 * j + 1] * __expf(bb[2 * j + 1]));
        }
        Aq[k2] = __builtin_bit_cast(bf16x8, a); Aqs[k2] = __builtin_bit_cast(bf16x8, as);
    }
    bf16_t* Aw = Ab + w * 16 * 136;
    for (int J = 0; J <= w; ++J) {
        f32x4 sc = (f32x4){0.f, 0.f, 0.f, 0.f};
#pragma unroll
        for (int k2 = 0; k2 < 2; ++k2) {
            const int k0 = k2 * 32 + fq * 8;
            const u32x4 kw = *(const u32x4*)(ks_ + (J * 16 + fr) * 72 + k0);
            const float* bk = bs + (J * 16 + fr) * 68 + k0;
            const f32x4 b0 = *(const f32x4*)bk, b1 = *(const f32x4*)(bk + 4);
            const f32x4 r0 = *(const f32x4*)(rho + k0), r1 = *(const f32x4*)(rho + k0 + 4);
            float kk[8] = {lo_f(kw[0]), hi_f(kw[0]), lo_f(kw[1]), hi_f(kw[1]), lo_f(kw[2]), hi_f(kw[2]), lo_f(kw[3]), hi_f(kw[3])};
            float bb[8] = {b0[0], b0[1], b0[2], b0[3], b1[0], b1[1], b1[2], b1[3]};
            float rr[8] = {r0[0], r0[1], r0[2], r0[3], r1[0], r1[1], r1[2], r1[3]};
            u32x4 bw;
#pragma unroll
            for (int j = 0; j < 4; ++j)
                bw[j] = pk2(kk[2 * j] * __expf(fminf(rr[2 * j] - bb[2 * j], 80.f)), kk[2 * j + 1] * __expf(fminf(rr[2 * j + 1] - bb[2 * j + 1], 80.f)));
            sc = MFMA16(Aq[k2], __builtin_bit_cast(bf16x8, bw), sc);
        }
#pragma unroll
        for (int reg = 0; reg < 4; ++reg) {
            const int tl = 4 * fq + reg;
            float val = sc[reg];
            if (J == w && fr > tl) val = 0.f;
            Aw[tl * 136 + J * 16 + fr] = (bf16_t)f2bf(val);
        }
    }
    if ((w & 1) == 0) {
#pragma unroll
        for (int reg = 0; reg < 4; ++reg) Aw[(4 * fq + reg) * 136 + (w + 1) * 16 + fr] = (bf16_t)0;
    }
    asm volatile("s_waitcnt lgkmcnt(0)" ::: "memory");
    f32x4 o[4];
#pragma unroll
    for (int i = 0; i < 4; ++i) o[i] = (f32x4){0.f, 0.f, 0.f, 0.f};
    const int nks = (16 * (w + 1) + 31) >> 5;
    for (int k2 = 0; k2 < nks; ++k2) {
        const bf16x8 A = *(const bf16x8*)(Aw + fr * 136 + k2 * 32 + fq * 8);
#pragma unroll
        for (int nt = 0; nt < 4; ++nt) {
            const bf16x8 B = *(const bf16x8*)(vT + (nt * 16 + fr) * 136 + k2 * 32 + fq * 8);
            o[nt] = MFMA16(A, B, o[nt]);
        }
    }
#pragma unroll
    for (int k2 = 0; k2 < 2; ++k2)
#pragma unroll
        for (int nt = 0; nt < 4; ++nt) {
            const bf16x8 B = *(const bf16x8*)(ST + (nt * 16 + fr) * 72 + k2 * 32 + fq * 8);
            o[nt] = MFMA16(Aqs[k2], B, o[nt]);
        }
    const float* ogp = c.og + L * 64;
#pragma unroll
    for (int reg = 0; reg < 4; ++reg) {
        float ssq = 0.f;
#pragma unroll
        for (int nt = 0; nt < 4; ++nt) ssq += o[nt][reg] * o[nt][reg];
        ssq += __shfl_xor(ssq, 1); ssq += __shfl_xor(ssq, 2); ssq += __shfl_xor(ssq, 4); ssq += __shfl_xor(ssq, 8);
        const float rinv = rsqrtf(ssq * (1.f / 64.f) + EPS);
        const size_t row = row0 + w * 16 + 4 * fq + reg;
#pragma unroll
        for (int nt = 0; nt < 4; ++nt) {
            const int v = nt * 16 + fr;
            const float y = o[nt][reg] * rinv * ogp[v] * bf2f(zg[nt][reg]);
            c.Y[row * DM + 256 + h * 64 + v] = (bf16_t)f2bf(y);
        }
    }
    __syncthreads();
}

DI int crow(int r, int hi) { return (r & 3) + 8 * (r >> 2) + 4 * hi; }
#define MX3(a, b, c) __builtin_fmaxf(__builtin_fmaxf((a), (b)), (c))
template <int ABL> DI f32x16 mm32(bf16x8 a, bf16x8 b, f32x16 c) {
    if constexpr (ABL == 1) { asm volatile("" :: "v"(a), "v"(b)); return c; } else return MFMA32(a, b, c);
}
template <int ABL> DI void fox_unit(const Ctx& c, int bh, int qb, unsigned char* lds) {
    const int tid = opaque_tid(), lane = tid & 63, wave = tid >> 6, r32 = lane & 31, hi = lane >> 5;
    const int b = bh >> 3, h = bh & 7;
    const size_t rowb = (size_t)b * SEQ;
    float* cL = (float*)lds;
    unsigned char* Kt = lds + 16384;
    unsigned char* Vt = lds + 16384 + 32768;
    float* wtot = (float*)(lds + 16384 + 32768 + 49152);
    const int nkeys = 256 * (qb + 1), NI = 2 * (qb + 1);
    f32x4 fl0 = (f32x4){0.f, 0.f, 0.f, 0.f}, fl1 = fl0;
    if (8 * tid < nkeys) { const f32x4* src = (const f32x4*)(c.FLOGT + (size_t)bh * SEQ + 8 * tid); fl0 = src[0]; fl1 = src[1]; }
    const int qrel = wave * 32 + r32;
    const size_t qrow = rowb + 256 * qb + qrel;
    bf16x8 qr[4];
#pragma unroll
    for (int ks = 0; ks < 4; ++ks) qr[ks] = *(const bf16x8*)(c.P + qrow * PW + 1792 + h * 64 + ks * 16 + hi * 8);
    const int skv = tid >> 3, sch = tid & 7;
    const bf16_t* kg = c.P + (rowb + skv) * PW + 2304 + h * 64 + sch * 8;
    const bf16_t* vg = c.P + (rowb + skv) * PW + 2816 + h * 64 + sch * 8;
    const int kst = skv * 128 + ((sch ^ ((skv >> 1) & 7)) * 16), vst = skv * 192 + sch * 16;
    u32x4 kreg0 = *(const u32x4*)kg, kreg1 = *(const u32x4*)(kg + (size_t)64 * PW), vreg0 = *(const u32x4*)vg, vreg1 = *(const u32x4*)(vg + (size_t)64 * PW);
    {
        float v[8]; float run = 0.f;
        if (8 * tid < nkeys) {
            const float t8[8] = {fl0[0], fl0[1], fl0[2], fl0[3], fl1[0], fl1[1], fl1[2], fl1[3]};
#pragma unroll
            for (int i = 0; i < 8; ++i) { run += t8[i]; v[i] = run; }
        } else {
#pragma unroll
            for (int i = 0; i < 8; ++i) v[i] = 0.f;
        }
        float inc = run;
#pragma unroll
        for (int o = 1; o < 64; o <<= 1) { const float t = __shfl_up(inc, o); if (lane >= o) inc += t; }
        if (lane == 63) wtot[wave] = inc;
        __syncthreads();
        float off = inc - run;
        for (int w2 = 0; w2 < wave; ++w2) off += wtot[w2];
        if (8 * tid < nkeys) {
            *(f32x4*)(cL + 8 * tid) = (f32x4){-(v[0] + off), -(v[1] + off), -(v[2] + off), -(v[3] + off)};
            *(f32x4*)(cL + 8 * tid + 4) = (f32x4){-(v[4] + off), -(v[5] + off), -(v[6] + off), -(v[7] + off)};
        }
    }
    *(u32x4*)(Kt + kst) = kreg0; *(u32x4*)(Kt + kst + 64 * 128) = kreg1; *(u32x4*)(Vt + vst) = vreg0; *(u32x4*)(Vt + vst + 64 * 192) = vreg1;
    __syncthreads();
    const float cq = -cL[256 * qb + qrel];
    float m_run = -1e30f, l_run = 0.f;
    f32x16 o0, o1;
#pragma unroll
    for (int i = 0; i < 16; ++i) { o0[i] = 0.f; o1[i] = 0.f; }
    const int vtr_base = (4 * hi + ((lane & 15) >> 2)) * 192 + (((lane >> 4) & 1) * 16 + (lane & 3) * 4) * 2;
    const int kfr_base = r32 * 128;
    int kch[4];
#pragma unroll
    for (int ks = 0; ks < 4; ++ks) kch[ks] = kfr_base + (((2 * ks + hi) ^ ((r32 >> 1) & 7)) * 16);
    asm volatile("" :: "v"(qr[0]), "v"(qr[1]), "v"(qr[2]), "v"(qr[3]));
    auto step = [&](int it, auto band_tag) __attribute__((always_inline)) {
        constexpr bool BAND = decltype(band_tag)::value;
        const int buf = it & 1;
        if (it + 1 < NI) {
            const size_t go = (size_t)(it + 1) * 128 * PW;
            kreg0 = *(const u32x4*)(kg + go); kreg1 = *(const u32x4*)(kg + go + (size_t)64 * PW); vreg0 = *(const u32x4*)(vg + go); vreg1 = *(const u32x4*)(vg + go + (size_t)64 * PW);
        }
        const int bandi = it - (NI - 2);
        const bool needA = !BAND || (128 * bandi <= 32 * wave + 31);
        const bool needB = !BAND || (128 * bandi + 64 <= 32 * wave + 31);
        if (needA) {
            const unsigned char* Kb = Kt + buf * 16384;
            const unsigned char* Vb = Vt + buf * 24576;
            f32x16 pa0, pa1, pb0, pb1;
            {
                const float* ct = cL + 128 * it + 4 * hi;
#pragma unroll
                for (int g4 = 0; g4 < 4; ++g4) {
                    f32x4 c0, c1, c2, c3; if constexpr (ABL == 2) { c0 = c1 = c2 = c3 = (f32x4){cq, cq, cq, cq}; } else { c0 = *(const f32x4*)(ct + 8 * g4); c1 = *(const f32x4*)(ct + 32 + 8 * g4); c2 = *(const f32x4*)(ct + 64 + 8 * g4); c3 = *(const f32x4*)(ct + 96 + 8 * g4); }
#pragma unroll
                    for (int i = 0; i < 4; ++i) { pa0[4 * g4 + i] = c0[i]; pa1[4 * g4 + i] = c1[i]; pb0[4 * g4 + i] = c2[i]; pb1[4 * g4 + i] = c3[i]; }
                }
            }
#pragma unroll
            for (int ks = 0; ks < 4; ++ks) {
                const bf16x8 k0 = (ABL == 2) ? qr[ks] : *(const bf16x8*)(Kb + kch[ks]);
                const bf16x8 k1 = (ABL == 2) ? qr[ks] : *(const bf16x8*)(Kb + kch[ks] + 32 * 128);
                pa0 = mm32<ABL>(k0, qr[ks], pa0);
                pa1 = mm32<ABL>(k1, qr[ks], pa1);
            }
            if (needB) {
#pragma unroll
                for (int ks = 0; ks < 4; ++ks) {
                    const bf16x8 k2 = (ABL == 2) ? qr[ks] : *(const bf16x8*)(Kb + kch[ks] + 64 * 128);
                    const bf16x8 k3 = (ABL == 2) ? qr[ks] : *(const bf16x8*)(Kb + kch[ks] + 96 * 128);
                    pb0 = mm32<ABL>(k2, qr[ks], pb0);
                    pb1 = mm32<ABL>(k3, qr[ks], pb1);
                }
            }
            if constexpr (BAND) {
                const int kb = 128 * bandi;
#pragma unroll
                for (int r = 0; r < 16; ++r) {
                    const int kv = kb + crow(r, hi);
                    if (kv > qrel) pa0[r] = -INFINITY;
                    if (kv + 32 > qrel) pa1[r] = -INFINITY;
                    if (kv + 64 > qrel) pb0[r] = -INFINITY;
                    if (kv + 96 > qrel) pb1[r] = -INFINITY;
                }
            }
            if constexpr (ABL != 3) {
            float ra = MX3(pa0[0], pa1[0], pb0[0]), rb2 = MX3(pb1[0], pa0[1], pa1[1]);
            ra = MX3(ra, pb0[1], pb1[1]);
#pragma unroll
            for (int r = 2; r < 16; r += 2) { ra = MX3(ra, pa0[r], pa1[r]); rb2 = MX3(rb2, pb0[r], pb1[r]); ra = MX3(ra, pa0[r + 1], pa1[r + 1]); rb2 = MX3(rb2, pb0[r + 1], pb1[r + 1]); }
            float rm = fmaxf(ra, rb2);
            rm = fmaxf(rm, __shfl_xor(rm, 32)) + cq;
            if (__any(rm > m_run + 6.f)) {
                const float m_new = fmaxf(m_run, rm);
                const float alpha = ex2_(m_run - m_new);
                m_run = m_new;
                l_run *= alpha;
#pragma unroll
                for (int r = 0; r < 16; ++r) { o0[r] *= alpha; o1[r] *= alpha; }
            }
            const float e = cq - m_run;
            float ps0 = 0.f, ps1 = 0.f;
#pragma unroll
            for (int r = 0; r < 16; ++r) {
                pa0[r] = ex2_(pa0[r] + e); pa1[r] = ex2_(pa1[r] + e); pb0[r] = ex2_(pb0[r] + e); pb1[r] = ex2_(pb1[r] + e);
                ps0 += pa0[r] + pa1[r]; ps1 += pb0[r] + pb1[r];
            }
            l_run += ps0 + ps1;
            }
            bf16x8 pf[8];
#define PKF(P, B) __builtin_bit_cast(bf16x8, (u32x4){pk2(P[B], P[B + 1]), pk2(P[B + 2], P[B + 3]), pk2(P[B + 4], P[B + 5]), pk2(P[B + 6], P[B + 7])})
            pf[0] = PKF(pa0, 0); pf[1] = PKF(pa0, 8); pf[2] = PKF(pa1, 0); pf[3] = PKF(pa1, 8);
            pf[4] = PKF(pb0, 0); pf[5] = PKF(pb0, 8); pf[6] = PKF(pb1, 0); pf[7] = PKF(pb1, 8);
#undef PKF
#pragma unroll
            for (int kk = 0; kk < 8; ++kk) {
                if (kk < 4 || needB) {
                    if constexpr (ABL == 2) { o0 = mm32<ABL>(pf[kk ^ 1], pf[kk], o0); o1 = mm32<ABL>(pf[kk ^ 2], pf[kk], o1); }
                    else {
                    const LAS unsigned char* vp = (const LAS unsigned char*)(Vb + vtr_base + (16 * kk) * 192);
                    const s16x4 l0 = __builtin_bit_cast(s16x4, __builtin_amdgcn_ds_read_tr16_b64_v4i16((LAS s16x4*)(vp)));
                    const s16x4 h0 = __builtin_bit_cast(s16x4, __builtin_amdgcn_ds_read_tr16_b64_v4i16((LAS s16x4*)(vp + 8 * 192)));
                    const s16x4 l1 = __builtin_bit_cast(s16x4, __builtin_amdgcn_ds_read_tr16_b64_v4i16((LAS s16x4*)(vp + 64)));
                    const s16x4 h1 = __builtin_bit_cast(s16x4, __builtin_amdgcn_ds_read_tr16_b64_v4i16((LAS s16x4*)(vp + 64 + 8 * 192)));
                    o0 = mm32<ABL>(((bf16x8){l0[0], l0[1], l0[2], l0[3], h0[0], h0[1], h0[2], h0[3]}), pf[kk], o0);
                    o1 = mm32<ABL>(((bf16x8){l1[0], l1[1], l1[2], l1[3], h1[0], h1[1], h1[2], h1[3]}), pf[kk], o1);
                    }
                }
            }
        }
        if (it + 1 < NI) {
            unsigned char* Kn = Kt + (buf ^ 1) * 16384; unsigned char* Vn = Vt + (buf ^ 1) * 24576;
            *(u32x4*)(Kn + kst) = kreg0; *(u32x4*)(Kn + kst + 64 * 128) = kreg1; *(u32x4*)(Vn + vst) = vreg0; *(u32x4*)(Vn + vst + 64 * 192) = vreg1;
        }
        __syncthreads();
    };
    for (int it = 0; it < NI - 2; ++it) step(it, std::false_type{});
    const bf16_t* zp = c.P + qrow * PW + 3328 + h * 64;
    u32x2 zwv[8];
#pragma unroll
    for (int dh = 0; dh < 2; ++dh)
#pragma unroll
        for (int g4 = 0; g4 < 4; ++g4) zwv[4 * dh + g4] = *(const u32x2*)(zp + 32 * dh + 8 * g4 + 4 * hi);
    for (int it = NI - 2; it < NI; ++it) step(it, std::true_type{});
    const float linv = 1.f / (l_run + __shfl_xor(l_run, 32));
    bf16_t* yp = (ABL ? (c.SB + (size_t)2 * 1024 * 1024 + (size_t)qrel * DM) : (c.Y + qrow * DM)) + 512 + h * 64;
    u32x2 pkq[8];
#pragma unroll
    for (int dh = 0; dh < 2; ++dh)
#pragma unroll
        for (int g4 = 0; g4 < 4; ++g4) {
            const u32x2 zw = zwv[4 * dh + g4];
            float ov[4];
#pragma unroll
            for (int i = 0; i < 4; ++i) ov[i] = (dh == 0 ? o0[4 * g4 + i] : o1[4 * g4 + i]) * linv;
            pkq[4 * dh + g4] = (u32x2){pk2(ov[0] * lo_f(zw[0]), ov[1] * hi_f(zw[0])), pk2(ov[2] * lo_f(zw[1]), ov[3] * hi_f(zw[1]))};
        }
#pragma unroll
    for (int kq = 0; kq < 8; kq += 2) {
        const auto rx = __builtin_amdgcn_permlane32_swap(pkq[kq][0], pkq[kq + 1][0], false, false);
        const auto ry = __builtin_amdgcn_permlane32_swap(pkq[kq][1], pkq[kq + 1][1], false, false);
        *(u32x4*)(yp + 8 * kq + (hi ? 8 : 0)) = (u32x4){rx[0], ry[0], rx[1], ry[1]};
    }
}
#undef MX3

__global__ void __launch_bounds__(NTHREADS, 2) fwd_kernel(Args a) {
    extern __shared__ __attribute__((aligned(16))) unsigned char lds[];
    cg::grid_group grid = cg::this_grid();
    const int G = gridDim.x, bx = blockIdx.x;
    const int vcu = (G % 8 == 0) ? (bx % 8) * (G / 8) + bx / 8 : bx;

    volatile LAS unsigned* st = (volatile LAS unsigned*)((LAS unsigned char*)lds + (LDS_BYTES - 64));
    if (threadIdx.x < 16) st[threadIdx.x] = 0u;
    __syncthreads();
    const XcdBarrier bar = xcd_barrier_post(g_ctl, st);
    if (G == 0x40000000) grid.sync();
#define GRID_BAR() xcd_barrier(bar)

    { const Ctx c = load_ctx(); prologue(c, vcu, G, lds); }
    GRID_BAR();
#ifdef P_SYNC10
    for (int i = 0; i < 10; ++i) GRID_BAR();
#endif
#ifdef P_PRO2
    { const Ctx c = load_ctx(); prologue(c, vcu, G, lds); }
    GRID_BAR();
#endif

    for (int L = 0; L < 2; ++L) {
#ifndef NO_GIN
        {
            const Ctx c = load_ctx();
            pg8::Gemm g{c.XB, c.WinT + (size_t)L * NPAD * 1024, M, NPAD, 1024};
            pg8::StaticOrder S; S.init(M, NPAD, G, bx);
            EpiIn E{c.P, c.LOGF, c.FLOGT, c.SS + L * M, c.LB + L * 256, c.bf + L * 8};
            pg8::gemm_phase<EpiIn, pg8::StaticOrder, true, true>((LAS unsigned char*)lds, g, S, E);
#ifdef P_GIN2
            __syncthreads();
            pg8::gemm_phase<EpiIn, pg8::StaticOrder, true, true>((LAS unsigned char*)lds, g, S, E);
#endif
        }
#endif
        GRID_BAR();
#ifndef NO_HU
        { const Ctx c = load_ctx(); for (int it = vcu; it < 512; it += 2 * G) hgrn_u_pair(c, it, it + G < 512 ? it + G : -1, lds, c.ctl + CW_HU + 64 * L); }
#endif
#ifndef NO_GM
        { const Ctx c = load_ctx(); for (int it = vcu; it < 512; it += 2 * G) gmlp_pair(c, L, it, it + G < 512 ? it + G : -1, lds); }
#endif
#ifndef NO_FOX
        { const Ctx c = load_ctx();
          for (int pi = vcu; pi < 256; pi += G) {
            const int bh = pi >> 3, s = pi & 7;
            for (int u = 0; u < 2; ++u) fox_unit<0>(c, bh, (u & 1) ? s : 15 - s, lds);
#ifdef P_ABL
            for (int u = 0; u < 2; ++u) fox_unit<P_ABL>(c, bh, (u & 1) ? s : 15 - s, lds);
#endif
          } }
#endif
        { const Ctx c = load_ctx(); for (int it = vcu; it < 32; it += G) hgrn_scan_item(c, it, c.ctl + CW_HU + 64 * L); }
        GRID_BAR();
#ifndef NO_HO
        { const Ctx c = load_ctx(); for (int it = vcu; it < 512; it += G) hgrn_o_item(c, L, it, lds); }
#ifdef P_HO2
        { const Ctx c = load_ctx(); for (int it = vcu; it < 512; it += G) hgrn_o_item(c, L, it, lds); }
#endif
#endif
        GRID_BAR();
#ifndef NO_GOUT
        {
            const Ctx c = load_ctx();
            pg8::Gemm g{c.Y, c.WoutT + (size_t)L * 1024 * 1024, M, 1024, 1024};
            pg8::StaticOrder S; S.init(M, 1024, G, bx);
#ifdef P_GOUT2
            { EpiOut E2{L == 0 ? c.x : c.out, (float*)c.P, c.P + (size_t)32 * 1024 * 1024, c.LOGF};
              pg8::gemm_phase<EpiOut, pg8::StaticOrder, false, true>((LAS unsigned char*)lds, g, S, E2); __syncthreads(); }
#endif
            if (L == 1 && G == 256) {
                EpiOutFinal E{c.out, c.out, c.SS + 2 * M, c.ctl + CW_PANEL, c.gfin};
                pg8::gemm_phase<EpiOutFinal, pg8::StaticOrder, true, true>((LAS unsigned char*)lds, g, S, E);
            } else {
                EpiOut E{L == 0 ? c.x : c.out, c.out, c.XB, c.SS + (L + 1) * M};
                pg8::gemm_phase<EpiOut, pg8::StaticOrder, true, true>((LAS unsigned char*)lds, g, S, E);
            }
        }
#endif
        if (!(L == 1 && G == 256)) GRID_BAR();
    }
    if (G != 256) {
        const Ctx c = load_ctx();
        const int tid = opaque_tid(), lane = tid & 63, wave = tid >> 6;
        for (int r = vcu * 8 + wave; r < M; r += G * 8) {
            const float rs = rsqrtf(c.SS[2 * M + r] * (1.f / DM) + EPS);
            f32x4* xr = (f32x4*)(c.out + (size_t)r * DM) + lane;
#pragma unroll
            for (int j = 0; j < 4; ++j) { f32x4 v = xr[64 * j]; const f32x4 gg = ((const f32x4*)c.gfin)[lane + 64 * j]; v = v * rs * gg; xr[64 * j] = v; }
        }
    }
    {
        const int tid = opaque_tid();
        asm volatile("s_waitcnt vmcnt(0)" ::: "memory");
        __syncthreads();
        if (tid == 0) st[4] = (xb_add(&g_ctl[CW_DONE], 1u) == (unsigned)(G - 1)) ? 1u : 0u;
        __syncthreads();
        if (st[4]) { for (int i = tid; i < CTL_WORDS; i += NTHREADS) __hip_atomic_store(&g_ctl[i], 0u, __ATOMIC_RELAXED, __HIP_MEMORY_SCOPE_AGENT); }
    }
}

extern "C" void kernel_launch(void* const* d_in, const int* in_sizes, int n_in, void* d_out, int out_size, void* d_ws, size_t ws_size, hipStream_t stream) {
    static int grid = 0;
    if (grid == 0) {
        int dev = 0, cus = 0, per_cu = 0;
        hipGetDevice(&dev);
        hipDeviceGetAttribute(&cus, hipDeviceAttributeMultiprocessorCount, dev);
        hipFuncSetAttribute((const void*)fwd_kernel, hipFuncAttributeMaxDynamicSharedMemorySize, LDS_BYTES);
        hipOccupancyMaxActiveBlocksPerMultiprocessor(&per_cu, (const void*)fwd_kernel, NTHREADS, LDS_BYTES);
        if (per_cu < 1) fprintf(stderr, "kernel_launch: occupancy query says %d blocks per CU\n", per_cu);
        grid = cus;
        (void)hipGetLastError();
    }
    Args a{};
    for (int i = 0; i < 12; ++i) a.in[i] = (const float*)d_in[i];
    a.out = (float*)d_out; a.ws = (unsigned char*)d_ws;
    void* args[] = {&a};
    hipError_t e = hipLaunchCooperativeKernel((const void*)fwd_kernel, dim3(grid), dim3(NTHREADS), args, LDS_BYTES, stream);
    if (e != hipSuccess) fprintf(stderr, "cooperative launch failed: %s (grid %d)\n", hipGetErrorString(e), grid);
}
```

```cpp
#include <hip/hip_runtime.h>
#include <hip/hip_cooperative_groups.h>
#include <cstdio>
#include <cstdint>
#include <type_traits>
namespace cg = cooperative_groups;
namespace pg8 {
#define PG8_LAS __attribute__((address_space(3)))
typedef unsigned short bf16_t;
typedef short bf16x8 __attribute__((ext_vector_type(8)));
typedef float f32x4 __attribute__((ext_vector_type(4)));
typedef unsigned u32x4 __attribute__((ext_vector_type(4)));
constexpr int BM = 256, BK = 64, HALF = 128, HTB = HALF * BK * 2  , STAGE_BYTES = 8 * HTB, NXCD = 8, WGM = 8;

__host__ __device__ __forceinline__ int lds_byte(int r, int c) { const int st = (r >> 4) * 2 + (c >> 5), rr = r & 15, cc = c & 31, ob = rr * 64 + cc * 2; return st * 1024 + (ob ^ (((ob >> 9) & 1) << 5)); }
__host__ __device__ __forceinline__ void stage_rc(int b, int& R, int& C) { const int st = b / 1024, sb = b % 1024, swz = sb ^ (((sb >> 9) & 1) << 5); R = (st >> 1) * 16 + swz / 64; C = (st & 1) * 32 + (swz % 64) / 2; }
__host__ __device__ __forceinline__ int perm32(int rho) { const int n = rho >> 4, i = rho & 15; return 8 * (i >> 2) + 4 * n + (i & 3); }

struct Unit { int pm, pn; };
struct Gemm { const bf16_t* A; const bf16_t* Bt; int M, N, K; };

struct StaticOrder {
    int nM, nN, nwg, G, c;
    __host__ __device__ void init(int M, int N, int G_, int c_) { nM = M / BM; nN = N / BM; nwg = nM * nN; G = G_; c = c_; }
    __host__ __device__ bool next(int i, Unit& u) const {
        const long L = (long)i * G + c; if (L >= nwg) return false;
        int wgid = (int)L; { const int q = nwg / NXCD, r = nwg % NXCD, xcd = wgid % NXCD, off = wgid / NXCD; wgid = (xcd < r ? xcd * (q + 1) : r * (q + 1) + (xcd - r) * q) + off; }
        const int nig = WGM * nN, gid = wgid / nig, fm = gid * WGM, gsz = (nM - fm) < WGM ? (nM - fm) : WGM;
        u.pm = fm + ((wgid % nig) % gsz); u.pn = (wgid % nig) / gsz; return true;
    }
    __device__ __forceinline__ void a_ready(const Unit&) const {}
    __device__ __forceinline__ void done(const Unit&) const {}
};

__device__ __forceinline__ unsigned cvt_pk_bf16(float lo, float hi) { unsigned r; asm volatile("v_cvt_pk_bf16_f32 %0, %1, %2" : "=v"(r) : "v"(lo), "v"(hi)); return r; }
template <class Epi, class Sched, bool ALIGN_EPI = false, bool SP2 = false>
__device__ __forceinline__ void gemm_phase(PG8_LAS unsigned char* lds, const Gemm g, const Sched& S, const Epi& E) {
    int tid_ = threadIdx.x; asm volatile("" : "+v"(tid_)); const int tid = tid_, wid = __builtin_amdgcn_readfirstlane(tid >> 6), lane = tid & 63, wr = wid >> 2, wc = wid & 3, fr = lane & 15, fq = lane >> 4;
    const int K = g.K, nt = K / BK;
    unsigned voffA[2], voffB[2];
#pragma unroll
    for (int i = 0; i < 2; ++i) { int R, C; stage_rc(tid * 16 + i * 8192, R, C); const int Rb = Epi::PERM ? ((R & ~31) + perm32(R & 31)) : R;
        voffA[i] = (unsigned)(R * K + C) * 2u; voffB[i] = (unsigned)(Rb * K + C) * 2u; }
    const size_t kstep = (size_t)(BK * 2);
    const size_t hstep = (size_t)HALF * K * 2;
    const size_t tstep = 2 * hstep;
    const unsigned ldsw = (unsigned)wid * 1024u;
    const int aoff = lds_byte(wr * 64 + fr, fq * 8), boff = lds_byte(wc * 32 + fr, fq * 8);
#define PG8_SA(b, h) (((b) * 2 + (h)) * HTB)
#define PG8_SB(b, h) ((4 + (b) * 2 + (h)) * HTB)
#define PG8_STAGE(bufoff, gbase, voff) do { _Pragma("unroll") for (int _i = 0; _i < 2; ++_i) \
        __builtin_amdgcn_global_load_lds((const unsigned*)((const char*)(gbase) + (voff)[_i]), (PG8_LAS unsigned*)(lds + (bufoff) + ldsw + _i * 8192), 16, 0, 0); } while (0)
#define PG8_LDA(dst, b, h) do { _Pragma("unroll") for (int m = 0; m < 4; ++m) _Pragma("unroll") for (int k = 0; k < 2; ++k) dst[m][k] = *(const PG8_LAS bf16x8*)(lds + PG8_SA(b, h) + aoff + m * 2048 + k * 1024); } while (0)
#define PG8_LDB(dst, b, h) do { _Pragma("unroll") for (int n = 0; n < 2; ++n) _Pragma("unroll") for (int k = 0; k < 2; ++k) dst[n][k] = *(const PG8_LAS bf16x8*)(lds + PG8_SB(b, h) + boff + n * 2048 + k * 1024); } while (0)
#define PG8_MMA(ai, bj, At, Bt) do { __builtin_amdgcn_s_setprio(1); _Pragma("unroll") for (int m = 0; m < 4; ++m) _Pragma("unroll") for (int n = 0; n < 2; ++n) _Pragma("unroll") for (int k = 0; k < 2; ++k) \
        acc[ai][bj][m][n] = __builtin_amdgcn_mfma_f32_16x16x32_bf16(Bt[n][k], At[m][k], acc[ai][bj][m][n], 0, 0, 0); __builtin_amdgcn_s_setprio(0); } while (0)
#define PG8_WAIT_V(n) asm volatile("s_waitcnt vmcnt(" #n ")" ::: "memory")
#define PG8_WAIT_L(n) asm volatile("s_waitcnt lgkmcnt(" #n ")" ::: "memory")
#define PG8_BAR __builtin_amdgcn_s_barrier()
#define PG8_SCHED __builtin_amdgcn_sched_barrier(0)
    Unit cur, nxt; int ui = 0;
    if (!S.next(0, cur)) return;
    f32x4 acc[2][2][4][2];
#pragma unroll
    for (int a = 0; a < 2; ++a)
#pragma unroll
        for (int b = 0; b < 2; ++b)
#pragma unroll
            for (int m = 0; m < 4; ++m)
#pragma unroll
                for (int n = 0; n < 2; ++n) acc[a][b][m][n] = (f32x4){0.f, 0.f, 0.f, 0.f};
    bf16x8 At[4][2], B0[2][2], B1[2][2];
    const char* cA = (const char*)g.A + (size_t)cur.pm * tstep; const char* cB = (const char*)g.Bt + (size_t)cur.pn * tstep;
    S.a_ready(cur);
    if constexpr (SP2) {
        PG8_STAGE(PG8_SB(0, 0), cB, voffB); PG8_STAGE(PG8_SB(0, 1), cB + hstep, voffB); PG8_STAGE(PG8_SA(0, 0), cA, voffA); PG8_STAGE(PG8_SA(0, 1), cA + hstep, voffA);
        if (wr == 1) PG8_BAR;
        PG8_WAIT_V(2); PG8_BAR;
        PG8_STAGE(PG8_SB(1, 0), cB + kstep, voffB); PG8_STAGE(PG8_SA(1, 0), cA + kstep, voffA); PG8_STAGE(PG8_SB(1, 1), cB + hstep + kstep, voffB);
        PG8_WAIT_V(6); PG8_BAR;
    } else {
        PG8_STAGE(PG8_SB(0, 0), cB, voffB); PG8_STAGE(PG8_SA(0, 0), cA, voffA); PG8_STAGE(PG8_SB(0, 1), cB + hstep, voffB); PG8_STAGE(PG8_SA(0, 1), cA + hstep, voffA);
        if (wr == 1) PG8_BAR;
        PG8_WAIT_V(4); PG8_BAR;
        PG8_STAGE(PG8_SB(1, 0), cB + kstep, voffB); PG8_STAGE(PG8_SA(1, 0), cA + kstep, voffA); PG8_STAGE(PG8_SB(1, 1), cB + hstep + kstep, voffB);
        PG8_WAIT_V(6); PG8_BAR;
    }
    for (;;) {
        const bool has_next = S.next(ui + 1, nxt);
        const char* nA = has_next ? (const char*)g.A + (size_t)nxt.pm * tstep : cA; const char* nB = has_next ? (const char*)g.Bt + (size_t)nxt.pn * tstep : cB;
        for (int t = 0; t < nt; t += 2) {
            const bool last = (t == nt - 2);
            const char* a1 = cA + (size_t)(t + 1) * kstep;
            const char* a2 = last ? nA : cA + (size_t)(t + 2) * kstep; const char* b2 = last ? nB : cB + (size_t)(t + 2) * kstep;
            const char* a3 = a2 + kstep; const char* b3 = b2 + kstep;
            if (last && has_next) S.a_ready(nxt);
            if constexpr (SP2) {
            PG8_LDB(B0, 0, 0); PG8_LDB(B1, 0, 1); PG8_SCHED; PG8_LDA(At, 0, 0); PG8_STAGE(PG8_SA(1, 1), a1 + hstep, voffA);
            PG8_WAIT_V(8); PG8_WAIT_L(0); PG8_BAR; PG8_MMA(0, 0, At, B0); PG8_MMA(0, 1, At, B1); PG8_BAR; PG8_SCHED;
            PG8_LDA(At, 0, 1); PG8_STAGE(PG8_SB(0, 0), b2, voffB); PG8_STAGE(PG8_SB(0, 1), b2 + hstep, voffB); PG8_STAGE(PG8_SA(0, 0), a2, voffA);
            PG8_WAIT_V(8); PG8_WAIT_L(0); PG8_BAR; PG8_MMA(1, 0, At, B0); PG8_MMA(1, 1, At, B1); PG8_BAR; PG8_SCHED;
            PG8_LDB(B0, 1, 0); PG8_LDB(B1, 1, 1); PG8_SCHED; PG8_LDA(At, 1, 0); PG8_STAGE(PG8_SA(0, 1), a2 + hstep, voffA);
            PG8_WAIT_V(8); PG8_WAIT_L(0); PG8_BAR; PG8_MMA(0, 0, At, B0); PG8_MMA(0, 1, At, B1); PG8_BAR; PG8_SCHED;
            PG8_LDA(At, 1, 1); PG8_STAGE(PG8_SB(1, 0), b3, voffB); PG8_STAGE(PG8_SB(1, 1), b3 + hstep, voffB); PG8_STAGE(PG8_SA(1, 0), a3, voffA);
            PG8_WAIT_V(8); PG8_WAIT_L(0); PG8_BAR; PG8_MMA(1, 0, At, B0); PG8_MMA(1, 1, At, B1); PG8_BAR; PG8_SCHED;
            } else {
            PG8_LDB(B0, 0, 0); PG8_SCHED; PG8_LDA(At, 0, 0); PG8_STAGE(PG8_SA(1, 1), a1 + hstep, voffA);
            PG8_WAIT_L(8); PG8_BAR; PG8_WAIT_L(0); PG8_MMA(0, 0, At, B0); PG8_BAR; PG8_SCHED;
            PG8_LDB(B1, 0, 1); PG8_STAGE(PG8_SB(0, 0), b2, voffB);
            PG8_BAR; PG8_WAIT_L(0); PG8_MMA(0, 1, At, B1); PG8_BAR;
            PG8_LDA(At, 0, 1); PG8_STAGE(PG8_SA(0, 0), a2, voffA);
            PG8_BAR; PG8_WAIT_L(0); PG8_MMA(1, 0, At, B0); PG8_BAR; PG8_SCHED;
            PG8_STAGE(PG8_SB(0, 1), b2 + hstep, voffB);
            PG8_WAIT_V(6); PG8_BAR; PG8_MMA(1, 1, At, B1); PG8_BAR;
            PG8_LDB(B0, 1, 0); PG8_SCHED; PG8_LDA(At, 1, 0); PG8_STAGE(PG8_SA(0, 1), a2 + hstep, voffA);
            PG8_WAIT_L(8); PG8_BAR; PG8_WAIT_L(0); PG8_MMA(0, 0, At, B0); PG8_BAR; PG8_SCHED;
            PG8_LDB(B1, 1, 1); PG8_STAGE(PG8_SB(1, 0), b3, voffB);
            PG8_BAR; PG8_WAIT_L(0); PG8_MMA(0, 1, At, B1); PG8_BAR;
            PG8_LDA(At, 1, 1); PG8_STAGE(PG8_SA(1, 0), a3, voffA);
            PG8_BAR; PG8_WAIT_L(0); PG8_MMA(1, 0, At, B0); PG8_BAR; PG8_SCHED;
            PG8_STAGE(PG8_SB(1, 1), b3 + hstep, voffB);
            PG8_WAIT_V(6); PG8_BAR; PG8_MMA(1, 1, At, B1); PG8_BAR;
            }
        }
        if constexpr (ALIGN_EPI) { if (wr == 0) PG8_BAR; }
        if constexpr (!Epi::AFTER_DRAIN) { E(acc, cur, wr, wc, fr, fq); S.done(cur); }
        if (!has_next) break;
#pragma unroll
        for (int a = 0; a < 2; ++a)
#pragma unroll
            for (int b = 0; b < 2; ++b)
#pragma unroll
                for (int m = 0; m < 4; ++m)
#pragma unroll
                    for (int n = 0; n < 2; ++n) acc[a][b][m][n] = (f32x4){0.f, 0.f, 0.f, 0.f};
        cur = nxt; cA = nA; cB = nB; ++ui;
        if constexpr (ALIGN_EPI) { if (wr == 1) PG8_BAR; }
    }
    PG8_WAIT_V(0);
    if constexpr (!ALIGN_EPI) { if (wr == 0) PG8_BAR; }
    PG8_BAR;
    if constexpr (Epi::AFTER_DRAIN) { E.fused(acc, cur, wr, wc, fr, fq, lds, wid, lane); S.done(cur); }
#undef PG8_SA
#undef PG8_SB
#undef PG8_STAGE
#undef PG8_LDA
#undef PG8_LDB
#undef PG8_MMA
#undef PG8_WAIT_V
#undef PG8_WAIT_L
#undef PG8_BAR
#undef PG8_SCHED
}
}

#define DI __device__ __forceinline__
typedef unsigned short bf16_t;
typedef short bf16x8 __attribute__((ext_vector_type(8)));
typedef short s16x4 __attribute__((ext_vector_type(4)));
typedef float f32x4 __attribute__((ext_vector_type(4)));
typedef float f32x16 __attribute__((ext_vector_type(16)));
typedef unsigned u32x4 __attribute__((ext_vector_type(4)));
typedef unsigned u32x2 __attribute__((ext_vector_type(2)));
#define LAS __attribute__((address_space(3)))

#define XB_TMO      128
#define XB_XCNT(j)  (256  + 64 * (j))
#define XB_XSUB(j)  (1280 + 64 * (j))
#define XB_XGEN(j)  (2304 + 64 * (j))
#define XB_TOP      3328
#define XB_TOPGEN   3392
#define XCD_BAR_WORDS 3456
#define XB_SPIN_CAP (1u << 18)

__device__ __forceinline__ unsigned xb_ld(unsigned* p)              { return __hip_atomic_load(p, __ATOMIC_RELAXED, __HIP_MEMORY_SCOPE_AGENT); }
__device__ __forceinline__ unsigned xb_add(unsigned* p, unsigned v) { return __hip_atomic_fetch_add(p, v, __ATOMIC_RELAXED, __HIP_MEMORY_SCOPE_AGENT); }
__device__ __forceinline__ unsigned xb_xcc_id() { return (unsigned)__builtin_amdgcn_s_getreg((3 << 11) | 20) & 0xFu; }
#define XB_SPIN(cond, bar) do { unsigned _sp = 0; while (cond) { __builtin_amdgcn_s_sleep(1); \
    if ((++_sp & 255u) == 0u) { if (xb_ld(&(bar)[XB_TMO])) break; if (_sp > XB_SPIN_CAP) { atomicAdd(&(bar)[XB_TMO], 1u); break; } } } } while (0)

struct XcdBarrier {
    unsigned* bar; unsigned x;
    volatile LAS unsigned* st;
};

__device__ __forceinline__ XcdBarrier xcd_barrier_post(unsigned* bar, volatile LAS unsigned* st) {
    XcdBarrier b; b.bar = bar; b.x = xb_xcc_id(); b.st = st;
    if (threadIdx.x == 0) (void)xb_add(&bar[XB_XCNT(b.x)], 1u);
    return b;
}
__device__ __forceinline__ void xcd_barrier_complete(unsigned* bar, unsigned x, unsigned& nloc, unsigned& nx) {
    const unsigned G = gridDim.x * gridDim.y * gridDim.z;
    unsigned sum, cnt, mine, sp = 0u;
    for (;;) {
        sum = 0u; cnt = 0u; mine = 0u;
#pragma unroll
        for (unsigned j = 0; j < 16; ++j) { const unsigned c = xb_ld(&bar[XB_XCNT(j)]); sum += c; cnt += (c > 0u) ? 1u : 0u; mine = (j == x) ? c : mine; }
        if (sum == G) break;
        __builtin_amdgcn_s_sleep(1);
        if ((++sp & 255u) == 0u) { if (xb_ld(&bar[XB_TMO])) break; if (sp > XB_SPIN_CAP) { atomicAdd(&bar[XB_TMO], 1u); break; } }
    }
    nloc = mine > 0u ? mine : 1u; nx = cnt > 0u ? cnt : 1u;
}

__device__ __forceinline__ void xcd_barrier(const XcdBarrier& b) {
    asm volatile("s_waitcnt vmcnt(0)" ::: "memory");
    __syncthreads();
    if (threadIdx.x == 0) {
        unsigned* bar = b.bar;
        __builtin_amdgcn_s_waitcnt(0);
        unsigned nloc = b.st[0], nx = b.st[1];
        if (nloc == 0u) { xcd_barrier_complete(bar, b.x, nloc, nx); b.st[0] = nloc; b.st[1] = nx; }
        const unsigned old = xb_add(&bar[XB_XSUB(b.x)], 1u);
        const unsigned gen = old / nloc;
        if (old + 1u == (gen + 1u) * nloc) {
            __builtin_amdgcn_fence(__ATOMIC_RELEASE, "agent");
            asm volatile("s_waitcnt vmcnt(0)" ::: "memory");
            const unsigned og = xb_add(&bar[XB_TOP], 1u);
            const unsigned tg = og / nx;
            if (og + 1u == (tg + 1u) * nx) xb_add(&bar[XB_TOPGEN], 1u);
            else XB_SPIN(xb_ld(&bar[XB_TOPGEN]) == tg, bar);
            __builtin_amdgcn_fence(__ATOMIC_ACQUIRE, "agent");
            xb_add(&bar[XB_XGEN(b.x)], 1u);
            asm volatile("s_waitcnt vmcnt(0)" ::: "memory");
        } else {
            XB_SPIN(xb_ld(&bar[XB_XGEN(b.x)]) == gen, bar);
            __builtin_amdgcn_fence(__ATOMIC_ACQUIRE, "agent");
            asm volatile("s_waitcnt vmcnt(0)" ::: "memory");
        }
    }
    __syncthreads();
}


constexpr int NTHREADS = 512;
constexpr int LDS_BYTES = 147456;
constexpr int M = 16384, DM = 1024, SEQ = 4096, NB = 4;
constexpr int DIN = 3848, NPAD = 4096, PW = 3840;
constexpr float EPS = 1e-6f;
constexpr float LOG2E = 1.4426950408889634f;
constexpr float C2 = 0.125f * LOG2E;

constexpr size_t MiB = 1u << 20;
constexpr size_t WS_WIN = 0;
constexpr size_t WS_WOUT = 16 * MiB;
constexpr size_t WS_SS = 20 * MiB;
constexpr size_t WS_LB = 20 * MiB + 512 * 1024;
constexpr size_t WS_FLOGT = 21 * MiB;
constexpr size_t WS_DD = 22 * MiB;
constexpr size_t WS_CTL = 23 * MiB, CTL_BYTES = 65536;
constexpr size_t WS_U = 24 * MiB;
constexpr size_t WS_XB = 32 * MiB;
constexpr size_t WS_Y = 64 * MiB;
constexpr size_t WS_LOGF = 96 * MiB;
constexpr size_t WS_P = 112 * MiB;
constexpr size_t WS_SB = 232 * MiB;
constexpr int CW_PANEL = 8192;
constexpr int CW_HU = 3584;

struct Args { const float* in[12]; float* out; unsigned char* ws; };

constexpr int CTL_WORDS = 16384, CW_DONE = 16000;
__device__ unsigned g_ctl[CTL_WORDS];

struct Ctx {
    const float *x, *norm_g, *w_in, *w_out, *ln_g, *ln_b, *w_s, *b_s, *hlb, *og, *bf, *gfin;
    float* out;
    bf16_t *WinT, *WoutT, *XB, *Y, *P;
    float *SS, *LB, *FLOGT, *DD, *U, *LOGF;
    bf16_t* SB; unsigned* ctl;
};

DI const void* karg_ptr(int byte_off) {
    const __attribute__((address_space(1))) void* p;
    asm volatile("s_load_dwordx2 %0, %1, %2\n\ts_waitcnt lgkmcnt(0)" : "=s"(p) : "s"(__builtin_amdgcn_kernarg_segment_ptr()), "i"(byte_off) : "memory");
    return (const void*)p;
}
#define KARG(i) karg_ptr((i) * 8)
DI Ctx load_ctx() {
    Ctx c;
    c.x = (const float*)KARG(0); c.norm_g = (const float*)KARG(1); c.w_in = (const float*)KARG(2); c.w_out = (const float*)KARG(3);
    c.ln_g = (const float*)KARG(4); c.ln_b = (const float*)KARG(5); c.w_s = (const float*)KARG(6); c.b_s = (const float*)KARG(7);
    c.hlb = (const float*)KARG(8); c.og = (const float*)KARG(9); c.bf = (const float*)KARG(10); c.gfin = (const float*)KARG(11);
    c.out = (float*)KARG(12);
    unsigned char* ws = (unsigned char*)KARG(13);
    c.WinT = (bf16_t*)(ws + WS_WIN); c.WoutT = (bf16_t*)(ws + WS_WOUT); c.XB = (bf16_t*)(ws + WS_XB); c.Y = (bf16_t*)(ws + WS_Y); c.P = (bf16_t*)(ws + WS_P);
    c.SS = (float*)(ws + WS_SS); c.LB = (float*)(ws + WS_LB); c.FLOGT = (float*)(ws + WS_FLOGT); c.DD = (float*)(ws + WS_DD); c.U = (float*)(ws + WS_U); c.LOGF = (float*)(ws + WS_LOGF);
    c.SB = (bf16_t*)(ws + WS_SB); c.ctl = g_ctl;
    return c;
}

DI int opaque_tid() { int t = threadIdx.x; asm volatile("" : "+v"(t)); return t; }
DI float bf2f(bf16_t b) { return __uint_as_float(((unsigned)b) << 16); }
typedef float f32x2_t __attribute__((ext_vector_type(2)));
typedef __bf16 bf16x2_t __attribute__((ext_vector_type(2)));
DI unsigned pk2(float lo, float hi) { const f32x2_t v = {lo, hi}; const bf16x2_t b = __builtin_convertvector(v, bf16x2_t); return __builtin_bit_cast(unsigned, b); }
DI unsigned f2bf(float f) { return pk2(f, 0.f) & 0xffffu; }
DI float lo_f(unsigned w) { return __uint_as_float(w << 16); }
DI float hi_f(unsigned w) { return __uint_as_float(w & 0xffff0000u); }
DI float wave_sum(float v) {
#pragma unroll
    for (int o = 1; o < 64; o <<= 1) v += __shfl_xor(v, o);
    return v;
}
DI float rcp_(float x) { return __builtin_amdgcn_rcpf(x); }
DI float ex2_(float x) { return __builtin_amdgcn_exp2f(x); }
DI float sigmoidf_(float z) { return rcp_(1.f + ex2_(-LOG2E * z)); }
DI float siluf_(float z) { return z * rcp_(1.f + ex2_(-LOG2E * z)); }
DI float geluf_(float x) { const float u = 0.7978845608028654f * (x + 0.044715f * x * x * x); return x * rcp_(1.f + ex2_(-2.f * LOG2E * u)); }
#define MFMA16(a, b, c) __builtin_amdgcn_mfma_f32_16x16x32_bf16((a), (b), (c), 0, 0, 0)
#define MFMA32(a, b, c) __builtin_amdgcn_mfma_f32_32x32x16_bf16((a), (b), (c), 0, 0, 0)

struct EpiIn {
    static constexpr bool PERM = true, AFTER_DRAIN = false;
    bf16_t* P; float* LOGF; float* FLOGT; const float* ss; const float* lb; const float* bfl;
    DI void operator()(const f32x4 (&acc)[2][2][4][2], const pg8::Unit& u, int wr, int wc, int fr, int fq) const {
        const int pn = u.pn;
        const int rowb = u.pm * 256 + wr * 64 + fr;
        float rsv[2][4];
#pragma unroll
        for (int ai = 0; ai < 2; ++ai)
#pragma unroll
            for (int m = 0; m < 4; ++m) rsv[ai][m] = ss[rowb + ai * 128 + m * 16];
#pragma unroll
        for (int ai = 0; ai < 2; ++ai)
#pragma unroll
            for (int m = 0; m < 4; ++m) rsv[ai][m] = rsqrtf(rsv[ai][m] * (1.f / DM) + EPS);
        if (pn == 15) {
            if (wc == 0 && fq == 0) {
#pragma unroll
                for (int ai = 0; ai < 2; ++ai)
#pragma unroll
                    for (int m = 0; m < 4; ++m) {
                        const int row = rowb + ai * 128 + m * 16;
                        const float rs = rsv[ai][m];
                        const int b = row >> 12, s = row & 4095;
#pragma unroll
                        for (int n = 0; n < 2; ++n)
#pragma unroll
                            for (int i = 0; i < 4; ++i) {
                                const int h = 4 * n + i;
                                const float t = acc[ai][0][m][n][i] * rs + bfl[h];
                                const float ls = fminf(t, 0.f) - log1pf(expf(-fabsf(t)));
                                FLOGT[(size_t)(b * 8 + h) * SEQ + s] = ls * LOG2E;
                            }
                    }
            }
            return;
        }
        int mode = 0; float scale = 1.f;
        if (pn <= 1) mode = 1;
        else if (pn == 2 || pn == 6 || pn >= 13) mode = 2;
        else if (pn == 3) { mode = 2; scale = 0.125f; }
        else if (pn == 4) mode = 3;
        else if (pn == 7 || pn == 8) scale = C2;
        const int cl = wc * 32 + 8 * fq;
#pragma unroll
        for (int ai = 0; ai < 2; ++ai)
#pragma unroll
            for (int m = 0; m < 4; ++m) {
                const int row = rowb + ai * 128 + m * 16;
                const float rs = rsv[ai][m];
#pragma unroll
                for (int bj = 0; bj < 2; ++bj) {
                    const int ct = bj * 128 + cl;
                    float v[8];
#pragma unroll
                    for (int i = 0; i < 4; ++i) { v[i] = acc[ai][bj][m][0][i] * rs; v[4 + i] = acc[ai][bj][m][1][i] * rs; }
                    if (mode == 1) {
#pragma unroll
                        for (int i = 0; i < 8; ++i) v[i] = geluf_(v[i]);
                    } else if (mode == 2) {
#pragma unroll
                        for (int i = 0; i < 8; ++i) v[i] = siluf_(v[i]) * scale;
                    } else if (mode == 3) {
                        float lf[8];
#pragma unroll
                        for (int i = 0; i < 8; ++i) {
                            const float l = lb[ct + i], z = v[i];
                            const float sg = sigmoidf_(z);
                            const float f = l + (1.f - l) * sg;
                            lf[i] = __logf(fmaxf(f, 1e-30f));
                            v[i] = (1.f - l) * sigmoidf_(-z);
                        }
                        float* lp = LOGF + (size_t)row * 256 + ct;
                        *(f32x4*)lp = (f32x4){lf[0], lf[1], lf[2], lf[3]};
                        *(f32x4*)(lp + 4) = (f32x4){lf[4], lf[5], lf[6], lf[7]};
                    } else {
#pragma unroll
                        for (int i = 0; i < 8; ++i) v[i] *= scale;
                    }
                    u32x4 w; w.x = pk2(v[0], v[1]); w.y = pk2(v[2], v[3]); w.z = pk2(v[4], v[5]); w.w = pk2(v[6], v[7]);
                    *(u32x4*)(P + (size_t)row * PW + pn * 256 + ct) = w;
                }
            }
    }
};

struct EpiOut {
    static constexpr bool PERM = true, AFTER_DRAIN = false;
    const float* xin; float* xout; bf16_t* XB; float* ssn;
    DI void operator()(const f32x4 (&acc)[2][2][4][2], const pg8::Unit& u, int wr, int wc, int fr, int fq) const {
        const int rowb = u.pm * 256 + wr * 64 + fr;
        const int cb = u.pn * 256 + wc * 32 + 8 * fq;
#pragma unroll
        for (int ai = 0; ai < 2; ++ai) {
            f32x4 xv[4][2][2];
#pragma unroll
            for (int m = 0; m < 4; ++m)
#pragma unroll
                for (int bj = 0; bj < 2; ++bj) {
                    const size_t o = (size_t)(rowb + ai * 128 + m * 16) * DM + cb + bj * 128;
                    xv[m][bj][0] = __builtin_nontemporal_load((const f32x4*)(xin + o)); xv[m][bj][1] = __builtin_nontemporal_load((const f32x4*)(xin + o + 4));
                }
#pragma unroll
            for (int m = 0; m < 4; ++m) {
                const int row = rowb + ai * 128 + m * 16;
                float sq = 0.f;
#pragma unroll
                for (int bj = 0; bj < 2; ++bj) {
                    const size_t o = (size_t)row * DM + cb + bj * 128;
                    f32x4 x0 = xv[m][bj][0], x1 = xv[m][bj][1];
                    x0 = x0 + acc[ai][bj][m][0]; x1 = x1 + acc[ai][bj][m][1];
                    *(f32x4*)(xout + o) = x0; *(f32x4*)(xout + o + 4) = x1;
                    u32x4 w; w.x = pk2(x0[0], x0[1]); w.y = pk2(x0[2], x0[3]); w.z = pk2(x1[0], x1[1]); w.w = pk2(x1[2], x1[3]);
                    *(u32x4*)(XB + o) = w;
                    sq += x0[0] * x0[0] + x0[1] * x0[1] + x0[2] * x0[2] + x0[3] * x0[3] + x1[0] * x1[0] + x1[1] * x1[1] + x1[2] * x1[2] + x1[3] * x1[3];
                }
                sq += __shfl_xor(sq, 16); sq += __shfl_xor(sq, 32);
                if (fq == 0) atomicAdd(ssn + row, sq);
            }
        }
    }
};

struct EpiOutFinal {
    static constexpr bool PERM = true, AFTER_DRAIN = false;
    const float* xin; float* out; float* ss; unsigned* pcnt; const float* gf;
    DI void operator()(const f32x4 (&acc_)[2][2][4][2], const pg8::Unit& u, int wr, int wc, int fr, int fq) const {
        f32x4 (&acc)[2][2][4][2] = const_cast<f32x4 (&)[2][2][4][2]>(acc_);
        const int rowb = u.pm * 256 + wr * 64 + fr;
        const int cb = u.pn * 256 + wc * 32 + 8 * fq;
#pragma unroll
        for (int ai = 0; ai < 2; ++ai)
#pragma unroll
            for (int m = 0; m < 4; ++m) {
                const int row = rowb + ai * 128 + m * 16;
                float sq = 0.f;
#pragma unroll
                for (int bj = 0; bj < 2; ++bj) {
                    const size_t o = (size_t)row * DM + cb + bj * 128;
                    const f32x4 x0 = __builtin_nontemporal_load((const f32x4*)(xin + o)) + acc[ai][bj][m][0], x1 = __builtin_nontemporal_load((const f32x4*)(xin + o + 4)) + acc[ai][bj][m][1];
                    acc[ai][bj][m][0] = x0; acc[ai][bj][m][1] = x1;
                    sq += x0[0] * x0[0] + x0[1] * x0[1] + x0[2] * x0[2] + x0[3] * x0[3] + x1[0] * x1[0] + x1[1] * x1[1] + x1[2] * x1[2] + x1[3] * x1[3];
                }
                sq += __shfl_xor(sq, 16); sq += __shfl_xor(sq, 32);
                if (fq == 0) atomicAdd(ss + row, sq);
            }
        asm volatile("s_waitcnt vmcnt(0)" ::: "memory");
        __syncthreads();
        if (threadIdx.x == 0) {
            __builtin_amdgcn_fence(__ATOMIC_RELEASE, "agent"); asm volatile("s_waitcnt vmcnt(0)" ::: "memory");
            unsigned* pc = pcnt + 64 * u.pm;
            xb_add(pc, 1u);
            unsigned sp = 0;
            while (xb_ld(pc) < 4u) { __builtin_amdgcn_s_sleep(1); if (++sp > (1u << 22)) break; }
            __builtin_amdgcn_fence(__ATOMIC_ACQUIRE, "agent"); asm volatile("s_waitcnt vmcnt(0)" ::: "memory");
        }
        __syncthreads();
#pragma unroll
        for (int ai = 0; ai < 2; ++ai)
#pragma unroll
            for (int m = 0; m < 4; ++m) {
                const int row = rowb + ai * 128 + m * 16;
                const float rs = rsqrtf(__hip_atomic_load(ss + row, __ATOMIC_RELAXED, __HIP_MEMORY_SCOPE_AGENT) * (1.f / DM) + EPS);
#pragma unroll
                for (int bj = 0; bj < 2; ++bj) {
                    const int col = cb + bj * 128;
                    const f32x4 g0 = *(const f32x4*)(gf + col), g1 = *(const f32x4*)(gf + col + 4);
                    const size_t o = (size_t)row * DM + col;
                    *(f32x4*)(out + o) = acc[ai][bj][m][0] * rs * g0; *(f32x4*)(out + o + 4) = acc[ai][bj][m][1] * rs * g1;
                }
            }
    }
};

DI void transpose_item(const float* W, int N, bf16_t* WT, const float* g, int kb, int nb, float* scr, int lane) {
    const int k0 = 64 * kb, n0 = 64 * nb;
    const bool nok = (n0 + lane) < N;
    float v[64];
#pragma unroll
    for (int i = 0; i < 64; ++i) v[i] = nok ? __builtin_nontemporal_load(W + (size_t)(k0 + i) * N + n0 + lane) : 0.f;
    if (g) {
#pragma unroll
        for (int i = 0; i < 64; ++i) v[i] *= g[k0 + i];
    }
#pragma unroll
    for (int i = 0; i < 64; ++i) scr[i * 65 + lane] = v[i];
    asm volatile("s_waitcnt lgkmcnt(0)" ::: "memory");
    const int cch = lane & 7;
#pragma unroll
    for (int j = 0; j < 8; ++j) {
        const int n = (lane >> 3) + 8 * j;
        const float* sp = scr + (8 * cch) * 65 + n;
        u32x4 o; o.x = pk2(sp[0], sp[65]); o.y = pk2(sp[2 * 65], sp[3 * 65]); o.z = pk2(sp[4 * 65], sp[5 * 65]); o.w = pk2(sp[6 * 65], sp[7 * 65]);
        if (n0 + n < N) *(u32x4*)(WT + (size_t)(n0 + n) * 1024 + k0 + 8 * cch) = o;
    }
    asm volatile("s_waitcnt lgkmcnt(0)" ::: "memory");
}

DI void prologue(const Ctx& c, int vcu, int G, unsigned char* lds) {
    const int tid = opaque_tid(), lane = tid & 63, wave = tid >> 6;
    const int gw = vcu * 8 + wave, NGW = G * 8;
    float* scr = (float*)lds + wave * (64 * 65);
#pragma unroll 8
    for (int r = vcu * 8 + wave; r < M; r += G * 8) {
        const f32x4* xr = (const f32x4*)(c.x + (size_t)r * DM) + 2 * lane;
        u32x4* o16 = (u32x4*)(c.XB + (size_t)r * DM) + lane;
        float s = 0.f;
#pragma unroll
        for (int j = 0; j < 2; ++j) {
            const f32x4 v = __builtin_nontemporal_load(xr + 128 * j), w = __builtin_nontemporal_load(xr + 128 * j + 1);
            s += v[0] * v[0] + v[1] * v[1] + v[2] * v[2] + v[3] * v[3] + w[0] * w[0] + w[1] * w[1] + w[2] * w[2] + w[3] * w[3];
            o16[64 * j] = (u32x4){pk2(v[0], v[1]), pk2(v[2], v[3]), pk2(w[0], w[1]), pk2(w[2], w[3])};
        }
        s = wave_sum(s);
        if (lane == 0) c.SS[r] = s;
    }
    constexpr int NB_IN = (DIN + 63) / 64, IT_IN = 16 * NB_IN, IT_OUT = 16 * 16;
    for (int it = gw; it < 2 * IT_IN + 2 * IT_OUT; it += NGW) {
        int r = it;
        if (r < 2 * IT_IN) { const int L = r / IT_IN; r -= L * IT_IN;
            transpose_item(c.w_in + (size_t)L * 1024 * DIN, DIN, c.WinT + (size_t)L * NPAD * 1024, c.norm_g + L * 1024, r / NB_IN, r % NB_IN, scr, lane); }
        else { r -= 2 * IT_IN; const int L = r / IT_OUT; r -= L * IT_OUT;
            transpose_item(c.w_out + (size_t)L * 1024 * 1024, 1024, c.WoutT + (size_t)L * 1024 * 1024, nullptr, r / 16, r % 16, scr, lane); }
    }
    for (int i = vcu * NTHREADS + tid; i < 2 * 248 * 128; i += G * NTHREADS) {
        const int L = i / (248 * 128), r = i % (248 * 128);
        *(u32x4*)(c.WinT + (size_t)L * NPAD * 1024 + (size_t)(DIN + r / 128) * 1024 + (r % 128) * 8) = (u32x4){0u, 0u, 0u, 0u};
    }
    for (int i = vcu * NTHREADS + tid; i < 2 * M; i += G * NTHREADS) c.SS[M + i] = 0.f;
    for (int i = vcu * NTHREADS + tid; i < 256; i += G * NTHREADS) {
        const float l0 = c.hlb[i], l1 = c.hlb[256 + i], mx = fmaxf(l0, l1);
        const float e0 = expf(l0 - mx), e1 = expf(l1 - mx);
        const float p0 = e0 / (e0 + e1), p1 = e1 / (e0 + e1);
        c.LB[i] = fminf(fmaxf(p0 - p0, 0.f), 1.f - 1e-6f);
        c.LB[256 + i] = fminf(fmaxf((p0 + p1) - p0, 0.f), 1.f - 1e-6f);
    }
}

DI void hgrn_cumsum(const float* LOGF, size_t row0, int h, float* segtot, float (&bl)[16], float& tot) {
    const int tid = opaque_tid(), k = tid & 63, seg = tid >> 6;
    const float* lf = LOGF + (row0 + seg * 16) * 256 + h * 64 + k;
    float run = 0.f;
#pragma unroll
    for (int i = 0; i < 16; ++i) { run += lf[(size_t)i * 256]; bl[i] = run; }
    segtot[seg * 64 + k] = run;
    __syncthreads();
    float off = 0.f; tot = 0.f;
#pragma unroll
    for (int s2 = 0; s2 < 8; ++s2) { const float v = segtot[s2 * 64 + k]; if (s2 < seg) off += v; tot += v; }
#pragma unroll
    for (int i = 0; i < 16; ++i) bl[i] += off;
}
DI void stage_colT(const bf16_t* P, size_t row0, int colbase, bf16_t* img) {
    const int tid = opaque_tid(), k = tid & 63, seg = tid >> 6;
    const bf16_t* p = P + (row0 + seg * 16) * PW + colbase + k;
    unsigned w[8];
#pragma unroll
    for (int i = 0; i < 8; ++i) w[i] = (unsigned)p[(size_t)(2 * i) * PW] | ((unsigned)p[(size_t)(2 * i + 1) * PW] << 16);
    u32x4* d = (u32x4*)(img + k * 136 + seg * 16);
    d[0] = (u32x4){w[0], w[1], w[2], w[3]}; d[1] = (u32x4){w[4], w[5], w[6], w[7]};
}

DI void hgrn_u_pair(const Ctx& c, int itA, int itB, unsigned char* lds, unsigned* cnt) {
    const int tid = opaque_tid(), lane = tid & 63, wave = tid >> 6, fr = lane & 15, fq = lane >> 4;
    const int k = tid & 63, seg = tid >> 6;
    const int items[2] = {itA, itB >= 0 ? itB : itA};
    constexpr int ISZ = 64 * 136 * 2 * 2 + 2048;
    float bl[2][16]; unsigned short kr[2][16];
    size_t row0[2]; int hh[2];
#pragma unroll
    for (int u = 0; u < 2; ++u) {
        const int item = items[u], b = item >> 7, h = (item >> 5) & 3, ch = item & 31;
        hh[u] = h; row0[u] = (size_t)b * SEQ + ch * 128;
        const float* lf = c.LOGF + (row0[u] + seg * 16) * 256 + h * 64 + k;
        const bf16_t* kp = c.P + (row0[u] + seg * 16) * PW + 1024 + h * 64 + k;
#pragma unroll
        for (int i = 0; i < 16; ++i) { bl[u][i] = lf[(size_t)i * 256]; kr[u][i] = kp[(size_t)i * PW]; }
    }
#pragma unroll
    for (int u = 0; u < 2; ++u) stage_colT(c.P, row0[u], 1280 + hh[u] * 64, (bf16_t*)(lds + u * ISZ) + 64 * 136);
#pragma unroll
    for (int u = 0; u < 2; ++u) {
        float* segtot = (float*)(lds + u * ISZ + 64 * 136 * 4);
        float run = 0.f;
#pragma unroll
        for (int i = 0; i < 16; ++i) { run += bl[u][i]; bl[u][i] = run; }
        segtot[seg * 64 + k] = run;
    }
    __syncthreads();
#pragma unroll
    for (int u = 0; u < 2; ++u) {
        const float* segtot = (const float*)(lds + u * ISZ + 64 * 136 * 4);
        bf16_t* kdT = (bf16_t*)(lds + u * ISZ);
        float off = 0.f, tot = 0.f;
#pragma unroll
        for (int s2 = 0; s2 < 8; ++s2) { const float v = segtot[s2 * 64 + k]; if (s2 < seg) off += v; tot += v; }
        const float tb = tot - off;
        unsigned w[8];
#pragma unroll
        for (int i = 0; i < 8; ++i)
            w[i] = pk2(bf2f(kr[u][2 * i]) * __expf(tb - bl[u][2 * i]), bf2f(kr[u][2 * i + 1]) * __expf(tb - bl[u][2 * i + 1]));
        u32x4* d = (u32x4*)(kdT + k * 136 + seg * 16);
        d[0] = (u32x4){w[0], w[1], w[2], w[3]}; d[1] = (u32x4){w[4], w[5], w[6], w[7]};
        if (seg == 0) c.DD[(size_t)items[u] * 64 + k] = __expf(tot);
    }
    __syncthreads();
    const int mt = wave >> 1, nt0 = (wave & 1) * 2;
#pragma unroll
    for (int u = 0; u < 2; ++u) {
        const bf16_t* kdT = (const bf16_t*)(lds + u * ISZ);
        const bf16_t* vT = kdT + 64 * 136;
        f32x4 acc[2] = {(f32x4){0.f, 0.f, 0.f, 0.f}, (f32x4){0.f, 0.f, 0.f, 0.f}};
#pragma unroll
        for (int ks = 0; ks < 4; ++ks) {
            const bf16x8 A = *(const bf16x8*)(kdT + (mt * 16 + fr) * 136 + ks * 32 + fq * 8);
#pragma unroll
            for (int n2 = 0; n2 < 2; ++n2) {
                const bf16x8 B = *(const bf16x8*)(vT + ((nt0 + n2) * 16 + fr) * 136 + ks * 32 + fq * 8);
                acc[n2] = MFMA16(A, B, acc[n2]);
            }
        }
        float* Up = c.U + (size_t)items[u] * 4096;
#pragma unroll
        for (int n2 = 0; n2 < 2; ++n2) *(f32x4*)(Up + ((nt0 + n2) * 16 + fr) * 64 + mt * 16 + fq * 4) = acc[n2];
    }
    asm volatile("s_waitcnt vmcnt(0)" ::: "memory");
    __syncthreads();
    if (tid == 0) { __builtin_amdgcn_fence(__ATOMIC_RELEASE, "agent"); asm volatile("s_waitcnt vmcnt(0)" ::: "memory"); xb_add(cnt, itB >= 0 ? 2u : 1u); }
}

DI void gmlp_pair(const Ctx& c, int L, int itA, int itB, unsigned char* lds) {
    const int tid = opaque_tid(), lane = tid & 63, wave = tid >> 6, fr = lane & 15, fq = lane >> 4;
    const int items[2] = {itA, itB >= 0 ? itB : itA};
    constexpr int VS = 136;
    size_t row0[2]; int gg[2];
    u32x4 w0[2], w1[2];
#pragma unroll
    for (int u = 0; u < 2; ++u) {
        const int item = items[u], b = item >> 7, n = (item >> 2) & 31, g = item & 3;
        gg[u] = g; row0[u] = (size_t)b * SEQ + n * 128;
        const bf16_t* src = c.P + (row0[u] + (tid >> 2)) * PW + 256 + g * 64 + (tid & 3) * 16;
        w0[u] = *(const u32x4*)src; w1[u] = *(const u32x4*)(src + 8);
    }
    unsigned short gur[2][4][4], szr[2][4][4];
#pragma unroll
    for (int u = 0; u < 2; ++u)
#pragma unroll
        for (int nt = 0; nt < 4; ++nt)
#pragma unroll
            for (int reg = 0; reg < 4; ++reg) {
                const size_t row = row0[u] + wave * 16 + fq * 4 + reg; const int cc = gg[u] * 64 + nt * 16 + fr;
                gur[u][nt][reg] = c.P[row * PW + cc]; szr[u][nt][reg] = c.P[row * PW + 512 + cc];
            }
#pragma unroll
    for (int u = 0; u < 2; ++u) {
        bf16_t* vnT = (bf16_t*)lds + u * 64 * VS;
        const int s = tid >> 2, part = tid & 3, g = gg[u];
        float x[16];
#pragma unroll
        for (int i = 0; i < 4; ++i) { x[2 * i] = lo_f(w0[u][i]); x[2 * i + 1] = hi_f(w0[u][i]); x[8 + 2 * i] = lo_f(w1[u][i]); x[8 + 2 * i + 1] = hi_f(w1[u][i]); }
        float sum = 0.f;
#pragma unroll
        for (int i = 0; i < 16; ++i) sum += x[i];
        sum += __shfl_xor(sum, 1); sum += __shfl_xor(sum, 2);
        const float mean = sum * (1.f / 64.f);
        float sq = 0.f;
#pragma unroll
        for (int i = 0; i < 16; ++i) { x[i] -= mean; sq += x[i] * x[i]; }
        sq += __shfl_xor(sq, 1); sq += __shfl_xor(sq, 2);
        const float rstd = rsqrtf(sq * (1.f / 64.f) + EPS);
        const float* lg = c.ln_g + L * 256 + g * 64 + part * 16;
        const float* lbp = c.ln_b + L * 256 + g * 64 + part * 16;
#pragma unroll
        for (int i = 0; i < 16; ++i) vnT[(part * 16 + i) * VS + s] = (bf16_t)f2bf(x[i] * rstd * lg[i] + lbp[i]);
    }
    __syncthreads();
    const int t = wave * 16 + fr;
    const int ksmax = (wave * 16 + 15) >> 5;
#pragma unroll
    for (int u = 0; u < 2; ++u) {
        const bf16_t* vnT = (const bf16_t*)lds + u * 64 * VS;
        const int g = gg[u];
        f32x4 acc[4];
#pragma unroll
        for (int i = 0; i < 4; ++i) acc[i] = (f32x4){0.f, 0.f, 0.f, 0.f};
        const float* wrow = c.w_s + ((size_t)(L * 4 + g) * 128 + t) * 128;
        for (int ks = 0; ks <= ksmax; ++ks) {
            const int s0 = ks * 32 + fq * 8;
            const f32x4 wa = *(const f32x4*)(wrow + s0), wb = *(const f32x4*)(wrow + s0 + 4);
            float wv[8] = {wa[0], wa[1], wa[2], wa[3], wb[0], wb[1], wb[2], wb[3]};
#pragma unroll
            for (int j = 0; j < 8; ++j) if (s0 + j > t) wv[j] = 0.f;
            u32x4 aw; aw.x = pk2(wv[0], wv[1]); aw.y = pk2(wv[2], wv[3]); aw.z = pk2(wv[4], wv[5]); aw.w = pk2(wv[6], wv[7]);
            const bf16x8 A = __builtin_bit_cast(bf16x8, aw);
#pragma unroll
            for (int nt = 0; nt < 4; ++nt) {
                const bf16x8 B = *(const bf16x8*)(vnT + (nt * 16 + fr) * VS + s0);
                acc[nt] = MFMA16(A, B, acc[nt]);
            }
        }
        const float* bsp = c.b_s + (size_t)(L * 4 + g) * 128 + wave * 16 + fq * 4;
#pragma unroll
        for (int nt = 0; nt < 4; ++nt) {
            const int cc = g * 64 + nt * 16 + fr;
#pragma unroll
            for (int reg = 0; reg < 4; ++reg) {
                const size_t row = row0[u] + wave * 16 + fq * 4 + reg;
                const float mixed = acc[nt][reg] + bsp[reg];
                c.Y[row * DM + cc] = (bf16_t)f2bf(bf2f(gur[u][nt][reg]) * mixed * bf2f(szr[u][nt][reg]));
            }
        }
    }
    __syncthreads();
}

DI void hgrn_scan_item(const Ctx& c, int item, unsigned* cnt) {
    const int tid = opaque_tid();
    if (tid == 0) {
        unsigned sp = 0;
        while (xb_ld(cnt) < 512u) { __builtin_amdgcn_s_sleep(1); if (++sp > (1u << 22)) break; }
        __builtin_amdgcn_fence(__ATOMIC_ACQUIRE, "agent");
        asm volatile("s_waitcnt vmcnt(0)" ::: "memory");
    }
    __syncthreads();
    const int bhh = item >> 1, vh = item & 1;
    const int v = vh * 32 + (tid >> 4), k4 = (tid & 15) * 4;
    const float* Ub = c.U + (size_t)bhh * 32 * 4096 + v * 64 + k4;
    const float* Db = c.DD + (size_t)bhh * 32 * 64 + k4;
    bf16_t* Sb = c.SB + (size_t)bhh * 32 * 4096 + v * 64 + k4;
    f32x4 S = (f32x4){0.f, 0.f, 0.f, 0.f};
    for (int j0 = 0; j0 < 32; j0 += 8) {
        f32x4 u[8], d[8];
#pragma unroll
        for (int j = 0; j < 8; ++j) { u[j] = *(const f32x4*)(Ub + (size_t)(j0 + j) * 4096); d[j] = *(const f32x4*)(Db + (size_t)(j0 + j) * 64); }
#pragma unroll
        for (int j = 0; j < 8; ++j) {
            *(u32x2*)(Sb + (size_t)(j0 + j) * 4096) = (u32x2){pk2(S[0], S[1]), pk2(S[2], S[3])};
            S = d[j] * S + u[j];
        }
    }
}

DI void hgrn_o_item(const Ctx& c, int L, int item, unsigned char* lds) {
    const int tid = opaque_tid(), lane = tid & 63, wave = tid >> 6, fr = lane & 15, fq = lane >> 4;
    const int b = item >> 7, h = (item >> 5) & 3, ch = item & 31;
    const size_t row0 = (size_t)b * SEQ + ch * 128;
    bf16_t* qs = (bf16_t*)lds;
    bf16_t* ks_ = qs + 128 * 72;
    float* bs = (float*)(ks_ + 128 * 72);
    bf16_t* vT = (bf16_t*)(bs + 128 * 68);
    bf16_t* ST = vT + 64 * 136;
    bf16_t* Ab = ST + 64 * 72;
    float* segtot = (float*)(Ab + 8 * 16 * 136);
    const int k = tid & 63, seg = tid >> 6;
    const u32x4 sbv = *(const u32x4*)(c.SB + (size_t)item * 4096 + (tid >> 3) * 64 + (tid & 7) * 8);
    float bl[16]; unsigned short vr[16];
    {
        const float* lf = c.LOGF + (row0 + seg * 16) * 256 + h * 64 + k;
        const bf16_t* vp = c.P + (row0 + seg * 16) * PW + 1280 + h * 64 + k;
#pragma unroll
        for (int i = 0; i < 16; ++i) { bl[i] = lf[(size_t)i * 256]; vr[i] = vp[(size_t)i * PW]; }
    }
    u32x4 qv[2], kv[2];
#pragma unroll
    for (int i = 0; i < 2; ++i) {
        const int id = tid + 512 * i, t = id >> 3, cc = id & 7;
        qv[i] = *(const u32x4*)(c.P + (row0 + t) * PW + 768 + h * 64 + cc * 8);
        kv[i] = *(const u32x4*)(c.P + (row0 + t) * PW + 1024 + h * 64 + cc * 8);
    }
    unsigned short zg[4][4];
#pragma unroll
    for (int nt = 0; nt < 4; ++nt)
#pragma unroll
        for (int reg = 0; reg < 4; ++reg) zg[nt][reg] = c.P[(row0 + wave * 16 + 4 * fq + reg) * PW + 1536 + h * 64 + nt * 16 + fr];
    *(u32x4*)(ST + (tid >> 3) * 72 + (tid & 7) * 8) = sbv;
#pragma unroll
    for (int i = 0; i < 2; ++i) {
        const int id = tid + 512 * i, t = id >> 3, cc = id & 7;
        *(u32x4*)(qs + t * 72 + cc * 8) = qv[i];
        *(u32x4*)(ks_ + t * 72 + cc * 8) = kv[i];
    }
    {
        u32x4* d = (u32x4*)(vT + k * 136 + seg * 16);
        d[0] = (u32x4){(unsigned)vr[0] | ((unsigned)vr[1] << 16), (unsigned)vr[2] | ((unsigned)vr[3] << 16), (unsigned)vr[4] | ((unsigned)vr[5] << 16), (unsigned)vr[6] | ((unsigned)vr[7] << 16)};
        d[1] = (u32x4){(unsigned)vr[8] | ((unsigned)vr[9] << 16), (unsigned)vr[10] | ((unsigned)vr[11] << 16), (unsigned)vr[12] | ((unsigned)vr[13] << 16), (unsigned)vr[14] | ((unsigned)vr[15] << 16)};
    }
    {
        float run = 0.f;
#pragma unroll
        for (int i = 0; i < 16; ++i) { run += bl[i]; bl[i] = run; }
        segtot[seg * 64 + k] = run;
    }
    __syncthreads();
    {
        float off = 0.f;
#pragma unroll
        for (int s2 = 0; s2 < 8; ++s2) { const float v = segtot[s2 * 64 + k]; if (s2 < seg) off += v; }
#pragma unroll
        for (int i = 0; i < 16; ++i) bs[(seg * 16 + i) * 68 + k] = bl[i] + off;
    }
    __syncthreads();
    const int w = wave;
    const float* brow = bs + (w * 16 + fr) * 68;
    const float* rho = bs + (w * 16) * 68;
    bf16x8 Aq[2], Aqs[2];
#pragma unroll
    for (int k2 = 0; k2 < 2; ++k2) {
        const int k0 = k2 * 32 + fq * 8;
        const u32x4 qw = *(const u32x4*)(qs + (w * 16 + fr) * 72 + k0);
        const f32x4 b0 = *(const f32x4*)(brow + k0), b1 = *(const f32x4*)(brow + k0 + 4);
        const f32x4 r0 = *(const f32x4*)(rho + k0), r1 = *(const f32x4*)(rho + k0 + 4);
        float q[8] = {lo_f(qw[0]), hi_f(qw[0]), lo_f(qw[1]), hi_f(qw[1]), lo_f(qw[2]), hi_f(qw[2]), lo_f(qw[3]), hi_f(qw[3])};
        float bb[8] = {b0[0], b0[1], b0[2], b0[3], b1[0], b1[1], b1[2], b1[3]};
        float rr[8] = {r0[0], r0[1], r0[2], r0[3], r1[0], r1[1], r1[2], r1[3]};
        u32x4 a, as;
#pragma unroll
        for (int j = 0; j < 4; ++j) {
            a[j] = pk2(q[2 * j] * __expf(bb[2 * j] - rr[2 * j]), q[2 * j + 1] * __expf(bb[2 * j + 1] - rr[2 * j + 1]));
            as[j] = pk2(q[2 * j] * __expf(bb[2 * j]), q[2 * j + 1] * __expf(bb[2 * j + 1]));
        }
        Aq[k2] = __builtin_bit_cast(bf16x8, a); Aqs[k2] = __builtin_bit_cast(bf16x8, as);
    }
    bf16_t* Aw = Ab + w * 16 * 136;
    for (int J = 0; J <= w; ++J) {
        f32x4 sc = (f32x4){0.f, 0.f, 0.f, 0.f};
#pragma unroll
        for (int k2 = 0; k2 < 2; ++k2) {
            const int k0 = k2 * 32 + fq * 8;
            const u32x4 kw = *(const u32x4*)(ks_ + (J * 16 + fr) * 72 + k0);
            const float* bk = bs + (J * 16 + fr) * 68 + k0;
            const f32x4 b0 = *(const f32x4*)bk, b1 = *(const f32x4*)(bk + 4);
            const f32x4 r0 = *(const f32x4*)(rho + k0), r1 = *(const f32x4*)(rho + k0 + 4);
            float kk[8] = {lo_f(kw[0]), hi_f(kw[0]), lo_f(kw[1]), hi_f(kw[1]), lo_f(kw[2]), hi_f(kw[2]), lo_f(kw[3]), hi_f(kw[3])};
            float bb[8] = {b0[0], b0[1], b0[2], b0[3], b1[0], b1[1], b1[2], b1[3]};
            float rr[8] = {r0[0], r0[1], r0[2], r0[3], r1[0], r1[1], r1[2], r1[3]};
            u32x4 bw;
#pragma unroll
            for (int j = 0; j < 4; ++j)
                bw[j] = pk2(kk[2 * j] * __expf(fminf(rr[2 * j] - bb[2 * j], 80.f)), kk[2 * j + 1] * __expf(fminf(rr[2 * j + 1] - bb[2 * j + 1], 80.f)));
            sc = MFMA16(Aq[k2], __builtin_bit_cast(bf16x8, bw), sc);
        }
#pragma unroll
        for (int reg = 0; reg < 4; ++reg) {
            const int tl = 4 * fq + reg;
            float val = sc[reg];
            if (J == w && fr > tl) val = 0.f;
            Aw[tl * 136 + J * 16 + fr] = (bf16_t)f2bf(val);
        }
    }
    if ((w & 1) == 0) {
#pragma unroll
        for (int reg = 0; reg < 4; ++reg) Aw[(4 * fq + reg) * 136 + (w + 1) * 16 + fr] = (bf16_t)0;
    }
    asm volatile("s_waitcnt lgkmcnt(0)" ::: "memory");
    f32x4 o[4];
#pragma unroll
    for (int i = 0; i < 4; ++i) o[i] = (f32x4){0.f, 0.f, 0.f, 0.f};
    const int nks = (16 * (w + 1) + 31) >> 5;
    for (int k2 = 0; k2 < nks; ++k2) {
        const bf16x8 A = *(const bf16x8*)(Aw + fr * 136 + k2 * 32 + fq * 8);
#pragma unroll
        for (int nt = 0; nt < 4; ++nt) {
            const bf16x8 B = *(const bf16x8*)(vT + (nt * 16 + fr) * 136 + k2 * 32 + fq * 8);
            o[nt] = MFMA16(A, B, o[nt]);
        }
    }
#pragma unroll
    for (int k2 = 0; k2 < 2; ++k2)
#pragma unroll
        for (int nt = 0; nt < 4; ++nt) {
            const bf16x8 B = *(const bf16x8*)(ST + (nt * 16 + fr) * 72 + k2 * 32 + fq * 8);
            o[nt] = MFMA16(Aqs[k2], B, o[nt]);
        }
    const float* ogp = c.og + L * 64;
#pragma unroll
    for (int reg = 0; reg < 4; ++reg) {
        float ssq = 0.f;
#pragma unroll
        for (int nt = 0; nt < 4; ++nt) ssq += o[nt][reg] * o[nt][reg];
        ssq += __shfl_xor(ssq, 1); ssq += __shfl_xor(ssq, 2); ssq += __shfl_xor(ssq, 4); ssq += __shfl_xor(ssq, 8);
        const float rinv = rsqrtf(ssq * (1.f / 64.f) + EPS);
        const size_t row = row0 + w * 16 + 4 * fq + reg;
#pragma unroll
        for (int nt = 0; nt < 4; ++nt) {
            const int v = nt * 16 + fr;
            const float y = o[nt][reg] * rinv * ogp[v] * bf2f(zg[nt][reg]);
            c.Y[row * DM + 256 + h * 64 + v] = (bf16_t)f2bf(y);
        }
    }
    __syncthreads();
}

DI int crow(int r, int hi) { return (r & 3) + 8 * (r >> 2) + 4 * hi; }
#define MX3(a, b, c) __builtin_fmaxf(__builtin_fmaxf((a), (b)), (c))
template <int ABL> DI f32x16 mm32(bf16x8 a, bf16x8 b, f32x16 c) {
    if constexpr (ABL == 1) { asm volatile("" :: "v"(a), "v"(b)); return c; } else return MFMA32(a, b, c);
}
template <int ABL> DI void fox_unit(const Ctx& c, int bh, int qb, unsigned char* lds) {
    const int tid = opaque_tid(), lane = tid & 63, wave = tid >> 6, r32 = lane & 31, hi = lane >> 5;
    const int b = bh >> 3, h = bh & 7;
    const size_t rowb = (size_t)b * SEQ;
    float* cL = (float*)lds;
    unsigned char* Kt = lds + 16384;
    unsigned char* Vt = lds + 16384 + 32768;
    float* wtot = (float*)(lds + 16384 + 32768 + 49152);
    const int nkeys = 256 * (qb + 1), NI = 2 * (qb + 1);
    f32x4 fl0 = (f32x4){0.f, 0.f, 0.f, 0.f}, fl1 = fl0;
    if (8 * tid < nkeys) { const f32x4* src = (const f32x4*)(c.FLOGT + (size_t)bh * SEQ + 8 * tid); fl0 = src[0]; fl1 = src[1]; }
    const int qrel = wave * 32 + r32;
    const size_t qrow = rowb + 256 * qb + qrel;
    bf16x8 qr[4];
#pragma unroll
    for (int ks = 0; ks < 4; ++ks) qr[ks] = *(const bf16x8*)(c.P + qrow * PW + 1792 + h * 64 + ks * 16 + hi * 8);
    const int skv = tid >> 3, sch = tid & 7;
    const bf16_t* kg = c.P + (rowb + skv) * PW + 2304 + h * 64 + sch * 8;
    const bf16_t* vg = c.P + (rowb + skv) * PW + 2816 + h * 64 + sch * 8;
    const int kst = skv * 128 + ((sch ^ ((skv >> 1) & 7)) * 16), vst = skv * 192 + sch * 16;
    u32x4 kreg0 = *(const u32x4*)kg, kreg1 = *(const u32x4*)(kg + (size_t)64 * PW), vreg0 = *(const u32x4*)vg, vreg1 = *(const u32x4*)(vg + (size_t)64 * PW);
    {
        float v[8]; float run = 0.f;
        if (8 * tid < nkeys) {
            const float t8[8] = {fl0[0], fl0[1], fl0[2], fl0[3], fl1[0], fl1[1], fl1[2], fl1[3]};
#pragma unroll
            for (int i = 0; i < 8; ++i) { run += t8[i]; v[i] = run; }
        } else {
#pragma unroll
            for (int i = 0; i < 8; ++i) v[i] = 0.f;
        }
        float inc = run;
#pragma unroll
        for (int o = 1; o < 64; o <<= 1) { const float t = __shfl_up(inc, o); if (lane >= o) inc += t; }
        if (lane == 63) wtot[wave] = inc;
        __syncthreads();
        float off = inc - run;
        for (int w2 = 0; w2 < wave; ++w2) off += wtot[w2];
        if (8 * tid < nkeys) {
            *(f32x4*)(cL + 8 * tid) = (f32x4){-(v[0] + off), -(v[1] + off), -(v[2] + off), -(v[3] + off)};
            *(f32x4*)(cL + 8 * tid + 4) = (f32x4){-(v[4] + off), -(v[5] + off), -(v[6] + off), -(v[7] + off)};
        }
    }
    *(u32x4*)(Kt + kst) = kreg0; *(u32x4*)(Kt + kst + 64 * 128) = kreg1; *(u32x4*)(Vt + vst) = vreg0; *(u32x4*)(Vt + vst + 64 * 192) = vreg1;
    __syncthreads();
    const float cq = -cL[256 * qb + qrel];
    float m_run = -1e30f, l_run = 0.f;
    f32x16 o0, o1;
#pragma unroll
    for (int i = 0; i < 16; ++i) { o0[i] = 0.f; o1[i] = 0.f; }
    const int vtr_base = (4 * hi + ((lane & 15) >> 2)) * 192 + (((lane >> 4) & 1) * 16 + (lane & 3) * 4) * 2;
    const int kfr_base = r32 * 128;
    int kch[4];
#pragma unroll
    for (int ks = 0; ks < 4; ++ks) kch[ks] = kfr_base + (((2 * ks + hi) ^ ((r32 >> 1) & 7)) * 16);
    asm volatile("" :: "v"(qr[0]), "v"(qr[1]), "v"(qr[2]), "v"(qr[3]));
    auto step = [&](int it, auto band_tag) __attribute__((always_inline)) {
        constexpr bool BAND = decltype(band_tag)::value;
        const int buf = it & 1;
        if (it + 1 < NI) {
            const size_t go = (size_t)(it + 1) * 128 * PW;
            kreg0 = *(const u32x4*)(kg + go); kreg1 = *(const u32x4*)(kg + go + (size_t)64 * PW); vreg0 = *(const u32x4*)(vg + go); vreg1 = *(const u32x4*)(vg + go + (size_t)64 * PW);
        }
        const int bandi = it - (NI - 2);
        const bool needA = !BAND || (128 * bandi <= 32 * wave + 31);
        const bool needB = !BAND || (128 * bandi + 64 <= 32 * wave + 31);
        if (needA) {
            const unsigned char* Kb = Kt + buf * 16384;
            const unsigned char* Vb = Vt + buf * 24576;
            f32x16 pa0, pa1, pb0, pb1;
            {
                const float* ct = cL + 128 * it + 4 * hi;
#pragma unroll
                for (int g4 = 0; g4 < 4; ++g4) {
                    f32x4 c0, c1, c2, c3; if constexpr (ABL == 2) { c0 = c1 = c2 = c3 = (f32x4){cq, cq, cq, cq}; } else { c0 = *(const f32x4*)(ct + 8 * g4); c1 = *(const f32x4*)(ct + 32 + 8 * g4); c2 = *(const f32x4*)(ct + 64 + 8 * g4); c3 = *(const f32x4*)(ct + 96 + 8 * g4); }
#pragma unroll
                    for (int i = 0; i < 4; ++i) { pa0[4 * g4 + i] = c0[i]; pa1[4 * g4 + i] = c1[i]; pb0[4 * g4 + i] = c2[i]; pb1[4 * g4 + i] = c3[i]; }
                }
            }
#pragma unroll
            for (int ks = 0; ks < 4; ++ks) {
                const bf16x8 k0 = (ABL == 2) ? qr[ks] : *(const bf16x8*)(Kb + kch[ks]);
                const bf16x8 k1 = (ABL == 2) ? qr[ks] : *(const bf16x8*)(Kb + kch[ks] + 32 * 128);
                pa0 = mm32<ABL>(k0, qr[ks], pa0);
                pa1 = mm32<ABL>(k1, qr[ks], pa1);
            }
            if (needB) {
#pragma unroll
                for (int ks = 0; ks < 4; ++ks) {
                    const bf16x8 k2 = (ABL == 2) ? qr[ks] : *(const bf16x8*)(Kb + kch[ks] + 64 * 128);
                    const bf16x8 k3 = (ABL == 2) ? qr[ks] : *(const bf16x8*)(Kb + kch[ks] + 96 * 128);
                    pb0 = mm32<ABL>(k2, qr[ks], pb0);
                    pb1 = mm32<ABL>(k3, qr[ks], pb1);
                }
            }
            if constexpr (BAND) {
                const int kb = 128 * bandi;
#pragma unroll
                for (int r = 0; r < 16; ++r) {
                    const int kv = kb + crow(r, hi);
                    if (kv > qrel) pa0[r] = -INFINITY;
                    if (kv + 32 > qrel) pa1[r] = -INFINITY;
                    if (kv + 64 > qrel) pb0[r] = -INFINITY;
                    if (kv + 96 > qrel) pb1[r] = -INFINITY;
                }
            }
            if constexpr (ABL != 3) {
            float ra = MX3(pa0[0], pa1[0], pb0[0]), rb2 = MX3(pb1[0], pa0[1], pa1[1]);
            ra = MX3(ra, pb0[1], pb1[1]);
#pragma unroll
            for (int r = 2; r < 16; r += 2) { ra = MX3(ra, pa0[r], pa1[r]); rb2 = MX3(rb2, pb0[r], pb1[r]); ra = MX3(ra, pa0[r + 1], pa1[r + 1]); rb2 = MX3(rb2, pb0[r + 1], pb1[r + 1]); }
            float rm = fmaxf(ra, rb2);
            rm = fmaxf(rm, __shfl_xor(rm, 32)) + cq;
            if (__any(rm > m_run + 6.f)) {
                const float m_new = fmaxf(m_run, rm);
                const float alpha = ex2_(m_run - m_new);
                m_run = m_new;
                l_run *= alpha;
#pragma unroll
                for (int r = 0; r < 16; ++r) { o0[r] *= alpha; o1[r] *= alpha; }
            }
            const float e = cq - m_run;
            float ps0 = 0.f, ps1 = 0.f;
#pragma unroll
            for (int r = 0; r < 16; ++r) {
                pa0[r] = ex2_(pa0[r] + e); pa1[r] = ex2_(pa1[r] + e); pb0[r] = ex2_(pb0[r] + e); pb1[r] = ex2_(pb1[r] + e);
                ps0 += pa0[r] + pa1[r]; ps1 += pb0[r] + pb1[r];
            }
            l_run += ps0 + ps1;
            }
            bf16x8 pf[8];
#define PKF(P, B) __builtin_bit_cast(bf16x8, (u32x4){pk2(P[B], P[B + 1]), pk2(P[B + 2], P[B + 3]), pk2(P[B + 4], P[B + 5]), pk2(P[B + 6], P[B + 7])})
            pf[0] = PKF(pa0, 0); pf[1] = PKF(pa0, 8); pf[2] = PKF(pa1, 0); pf[3] = PKF(pa1, 8);
            pf[4] = PKF(pb0, 0); pf[5] = PKF(pb0, 8); pf[6] = PKF(pb1, 0); pf[7] = PKF(pb1, 8);
#undef PKF
#pragma unroll
            for (int kk = 0; kk < 8; ++kk) {
                if (kk < 4 || needB) {
                    if constexpr (ABL == 2) { o0 = mm32<ABL>(pf[kk ^ 1], pf[kk], o0); o1 = mm32<ABL>(pf[kk ^ 2], pf[kk], o1); }
                    else {
                    const LAS unsigned char* vp = (const LAS unsigned char*)(Vb + vtr_base + (16 * kk) * 192);
                    const s16x4 l0 = __builtin_bit_cast(s16x4, __builtin_amdgcn_ds_read_tr16_b64_v4i16((LAS s16x4*)(vp)));
                    const s16x4 h0 = __builtin_bit_cast(s16x4, __builtin_amdgcn_ds_read_tr16_b64_v4i16((LAS s16x4*)(vp + 8 * 192)));
                    const s16x4 l1 = __builtin_bit_cast(s16x4, __builtin_amdgcn_ds_read_tr16_b64_v4i16((LAS s16x4*)(vp + 64)));
                    const s16x4 h1 = __builtin_bit_cast(s16x4, __builtin_amdgcn_ds_read_tr16_b64_v4i16((LAS s16x4*)(vp + 64 + 8 * 192)));
                    o0 = mm32<ABL>(((bf16x8){l0[0], l0[1], l0[2], l0[3], h0[0], h0[1], h0[2], h0[3]}), pf[kk], o0);
                    o1 = mm32<ABL>(((bf16x8){l1[0], l1[1], l1[2], l1[3], h1[0], h1[1], h1[2], h1[3]}), pf[kk], o1);
                    }
                }
            }
        }
        if (it + 1 < NI) {
            unsigned char* Kn = Kt + (buf ^ 1) * 16384; unsigned char* Vn = Vt + (buf ^ 1) * 24576;
            *(u32x4*)(Kn + kst) = kreg0; *(u32x4*)(Kn + kst + 64 * 128) = kreg1; *(u32x4*)(Vn + vst) = vreg0; *(u32x4*)(Vn + vst + 64 * 192) = vreg1;
        }
        __syncthreads();
    };
    for (int it = 0; it < NI - 2; ++it) step(it, std::false_type{});
    const bf16_t* zp = c.P + qrow * PW + 3328 + h * 64;
    u32x2 zwv[8];
#pragma unroll
    for (int dh = 0; dh < 2; ++dh)
#pragma unroll
        for (int g4 = 0; g4 < 4; ++g4) zwv[4 * dh + g4] = *(const u32x2*)(zp + 32 * dh + 8 * g4 + 4 * hi);
    for (int it = NI - 2; it < NI; ++it) step(it, std::true_type{});
    const float linv = 1.f / (l_run + __shfl_xor(l_run, 32));
    bf16_t* yp = (ABL ? (c.SB + (size_t)2 * 1024 * 1024 + (size_t)qrel * DM) : (c.Y + qrow * DM)) + 512 + h * 64;
    u32x2 pkq[8];
#pragma unroll
    for (int dh = 0; dh < 2; ++dh)
#pragma unroll
        for (int g4 = 0; g4 < 4; ++g4) {
            const u32x2 zw = zwv[4 * dh + g4];
            float ov[4];
#pragma unroll
            for (int i = 0; i < 4; ++i) ov[i] = (dh == 0 ? o0[4 * g4 + i] : o1[4 * g4 + i]) * linv;
            pkq[4 * dh + g4] = (u32x2){pk2(ov[0] * lo_f(zw[0]), ov[1] * hi_f(zw[0])), pk2(ov[2] * lo_f(zw[1]), ov[3] * hi_f(zw[1]))};
        }
#pragma unroll
    for (int kq = 0; kq < 8; kq += 2) {
        const auto rx = __builtin_amdgcn_permlane32_swap(pkq[kq][0], pkq[kq + 1][0], false, false);
        const auto ry = __builtin_amdgcn_permlane32_swap(pkq[kq][1], pkq[kq + 1][1], false, false);
        *(u32x4*)(yp + 8 * kq + (hi ? 8 : 0)) = (u32x4){rx[0], ry[0], rx[1], ry[1]};
    }
}
#undef MX3

__global__ void __launch_bounds__(NTHREADS, 2) fwd_kernel(Args a) {
    extern __shared__ __attribute__((aligned(16))) unsigned char lds[];
    cg::grid_group grid = cg::this_grid();
    const int G = gridDim.x, bx = blockIdx.x;
    const int vcu = (G % 8 == 0) ? (bx % 8) * (G / 8) + bx / 8 : bx;

    volatile LAS unsigned* st = (volatile LAS unsigned*)((LAS unsigned char*)lds + (LDS_BYTES - 64));
    if (threadIdx.x < 16) st[threadIdx.x] = 0u;
    __syncthreads();
    const XcdBarrier bar = xcd_barrier_post(g_ctl, st);
    if (G == 0x40000000) grid.sync();
#define GRID_BAR() xcd_barrier(bar)

    { const Ctx c = load_ctx(); prologue(c, vcu, G, lds); }
    GRID_BAR();
#ifdef P_SYNC10
    for (int i = 0; i < 10; ++i) GRID_BAR();
#endif
#ifdef P_PRO2
    { const Ctx c = load_ctx(); prologue(c, vcu, G, lds); }
    GRID_BAR();
#endif

    for (int L = 0; L < 2; ++L) {
#ifndef NO_GIN
        {
            const Ctx c = load_ctx();
            pg8::Gemm g{c.XB, c.WinT + (size_t)L * NPAD * 1024, M, NPAD, 1024};
            pg8::StaticOrder S; S.init(M, NPAD, G, bx);
            EpiIn E{c.P, c.LOGF, c.FLOGT, c.SS + L * M, c.LB + L * 256, c.bf + L * 8};
            pg8::gemm_phase<EpiIn, pg8::StaticOrder, true, true>((LAS unsigned char*)lds, g, S, E);
#ifdef P_GIN2
            __syncthreads();
            pg8::gemm_phase<EpiIn, pg8::StaticOrder, true, true>((LAS unsigned char*)lds, g, S, E);
#endif
        }
#endif
        GRID_BAR();
#ifndef NO_HU
        { const Ctx c = load_ctx(); for (int it = vcu; it < 512; it += 2 * G) hgrn_u_pair(c, it, it + G < 512 ? it + G : -1, lds, c.ctl + CW_HU + 64 * L); }
#endif
#ifndef NO_GM
        { const Ctx c = load_ctx(); for (int it = vcu; it < 512; it += 2 * G) gmlp_pair(c, L, it, it + G < 512 ? it + G : -1, lds); }
#endif
#ifndef NO_FOX
        { const Ctx c = load_ctx();
          for (int pi = vcu; pi < 256; pi += G) {
            const int bh = pi >> 3, s = pi & 7;
            for (int u = 0; u < 2; ++u) fox_unit<0>(c, bh, (u & 1) ? s : 15 - s, lds);
#ifdef P_ABL
            for (int u = 0; u < 2; ++u) fox_unit<P_ABL>(c, bh, (u & 1) ? s : 15 - s, lds);
#endif
          } }
#endif
        { const Ctx c = load_ctx(); for (int it = vcu; it < 32; it += G) hgrn_scan_item(c, it, c.ctl + CW_HU + 64 * L); }
        GRID_BAR();
#ifndef NO_HO
        { const Ctx c = load_ctx(); for (int it = vcu; it < 512; it += G) hgrn_o_item(c, L, it, lds); }
#ifdef P_HO2
        { const Ctx c = load_ctx(); for (int it = vcu; it < 512; it += G) hgrn_o_item(c, L, it, lds); }
#endif
#endif
        GRID_BAR();
#ifndef NO_GOUT
        {
            const Ctx c = load_ctx();
            pg8::Gemm g{c.Y, c.WoutT + (size_t)L * 1024 * 1024, M, 1024, 1024};
            pg8::StaticOrder S; S.init(M, 1024, G, bx);
#ifdef P_GOUT2
            { EpiOut E2{L == 0 ? c.x : c.out, (float*)c.P, c.P + (size_t)32 * 1024 * 1024, c.LOGF};
              pg8::gemm_phase<EpiOut, pg8::StaticOrder, false, true>((LAS unsigned char*)lds, g, S, E2); __syncthreads(); }
#endif
            if (L == 1 && G == 256) {
                EpiOutFinal E{c.out, c.out, c.SS + 2 * M, c.ctl + CW_PANEL, c.gfin};
                pg8::gemm_phase<EpiOutFinal, pg8::StaticOrder, true, true>((LAS unsigned char*)lds, g, S, E);
            } else {
                EpiOut E{L == 0 ? c.x : c.out, c.out, c.XB, c.SS + (L + 1) * M};
                pg8::gemm_phase<EpiOut, pg8::StaticOrder, true, true>((LAS unsigned char*)lds, g, S, E);
            }
        }
#endif
        if (!(L == 1 && G == 256)) GRID_BAR();
    }
    if (G != 256) {
        const Ctx c = load_ctx();
        const int tid = opaque_tid(), lane = tid & 63, wave = tid >> 6;
        for (int r = vcu * 8 + wave; r < M; r += G * 8) {
            const float rs = rsqrtf(c.SS[2 * M + r] * (1.f / DM) + EPS);
            f32x4* xr = (f32x4*)(c.out + (size_t)r * DM) + lane;
#pragma unroll
            for (int j = 0; j < 4; ++j) { f32x4 v = xr[64 * j]; const f32x4 gg = ((const f32x4*)c.gfin)[lane + 64 * j]; v = v * rs * gg; xr[64 * j] = v; }
        }
    }
    {
        const int tid = opaque_tid();
        asm volatile("s_waitcnt vmcnt(0)" ::: "memory");
        __syncthreads();
        if (tid == 0) st[4] = (xb_add(&g_ctl[CW_DONE], 1u) == (unsigned)(G - 1)) ? 1u : 0u;
        __syncthreads();
        if (st[4]) { for (int i = tid; i < CTL_WORDS; i += NTHREADS) __hip_atomic_store(&g_ctl[i], 0u, __ATOMIC_RELAXED, __HIP_MEMORY_SCOPE_AGENT); }
    }
}

extern "C" void kernel_launch(void* const* d_in, const int* in_sizes, int n_in, void* d_out, int out_size, void* d_ws, size_t ws_size, hipStream_t stream) {
    static int grid = 0;
    if (grid == 0) {
        int dev = 0, cus = 0, per_cu = 0;
        hipGetDevice(&dev);
        hipDeviceGetAttribute(&cus, hipDeviceAttributeMultiprocessorCount, dev);
        hipFuncSetAttribute((const void*)fwd_kernel, hipFuncAttributeMaxDynamicSharedMemorySize, LDS_BYTES);
        hipOccupancyMaxActiveBlocksPerMultiprocessor(&per_cu, (const void*)fwd_kernel, NTHREADS, LDS_BYTES);
        if (per_cu < 1) fprintf(stderr, "kernel_launch: occupancy query says %d blocks per CU\n", per_cu);
        grid = cus;
        (void)hipGetLastError();
    }
    Args a{};
    for (int i = 0; i < 12; ++i) a.in[i] = (const float*)d_in[i];
    a.out = (float*)d_out; a.ws = (unsigned char*)d_ws;
    void* args[] = {&a};
    hipError_t e = hipLaunchCooperativeKernel((const void*)fwd_kernel, dim3(grid), dim3(NTHREADS), args, LDS_BYTES, stream);
    if (e != hipSuccess) fprintf(stderr, "cooperative launch failed: %s (grid %d)\n", hipGetErrorString(e), grid);
}
```
